# Optimizing an MI355X kernel written in HIP

```python
import math
import jax, jax.numpy as jnp
from jax import lax
import numpy as np

D_MODEL = 2048
BATCH = 16
SEQ = 2048
DEPTH = 1

CHUNK = 64
Q_BLOCK = 128
MAX_OFFSET = 65536

MLA_HEADS = 8
Q_LORA = 512
KV_LORA = 256
NOPE_DIM = 128
ROPE_DIM = 64
V_DIM = 128
ROPE_THETA = 10000.0

FOX_HEADS = 8
FOX_HEAD_DIM = 128

D_FF = 5632
CONV_WIDTH = 3

N_BRANCHES = 2
EPS = 1e-6
NEG_INF = -1e30

SPLITS = (
    Q_LORA,
    KV_LORA,
    ROPE_DIM,
    FOX_HEADS * FOX_HEAD_DIM,
    FOX_HEADS * FOX_HEAD_DIM,
    FOX_HEADS * FOX_HEAD_DIM,
    FOX_HEADS,
    N_BRANCHES * D_MODEL,
)
D_IN = sum(SPLITS)

kernel_name = "hybrid_mla_fox_convffn_block"


def rmsnorm(x, g):
    xf = x.astype(jnp.float32)
    y = xf * lax.rsqrt(jnp.mean(xf * xf, axis=-1, keepdims=True) + EPS)
    return (y * g.astype(jnp.float32)).astype(x.dtype)


def rope(x, cos, sin):
    half = x.shape[-1] // 2
    x1, x2 = x[..., :half], x[..., half:]
    return jnp.concatenate([x1 * cos - x2 * sin, x2 * cos + x1 * sin], axis=-1)


def rope_tables(positions, dtype):
    inv_freq = 1.0 / (ROPE_THETA ** (jnp.arange(0, ROPE_DIM, 2, dtype=jnp.float32) / ROPE_DIM))
    ang = positions.astype(jnp.float32)[..., None] * inv_freq
    return jnp.cos(ang).astype(dtype), jnp.sin(ang).astype(dtype)


def block_attention(q, k, v, causal_unit, log_decay=None):
    S = q.shape[1]
    scale = q.shape[-1] ** -0.5
    pos = jnp.arange(S)
    outs = []
    for i in range(S // Q_BLOCK):
        start, end = i * Q_BLOCK, (i + 1) * Q_BLOCK
        s = jnp.einsum('bqhd,bkhd->bhqk', q[:, start:end], k[:, :end]).astype(jnp.float32) * scale
        if log_decay is not None:
            s = s + log_decay[:, :, start:end, None] - log_decay[:, :, None, :end]
        visible = (pos[None, :end] // causal_unit) <= (pos[start:end, None] // causal_unit)
        s = jnp.where(visible, s, NEG_INF)
        p = jax.nn.softmax(s, axis=-1)
        outs.append(jnp.einsum('bhqk,bkhd->bqhd', p.astype(v.dtype), v[:, :end]))
    return jnp.concatenate(outs, axis=1)


def setup_inputs(seed: int = 0) -> dict:
    key = jax.random.key(seed)
    ks = jax.random.split(key, 24)
    f32 = jnp.float32
    nrm = lambda k, shape, fan_in: jax.random.normal(k, shape, f32) * (fan_in ** -0.5)
    gain = lambda k, n: 1.0 + 0.05 * jax.random.normal(k, (n,), f32)
    offset = jax.random.randint(ks[1], (BATCH, 1), 0, MAX_OFFSET, dtype=jnp.int32)
    positions = offset + jnp.arange(SEQ, dtype=jnp.int32)[None, :]
    return {
        "x": jax.random.normal(ks[0], (BATCH, SEQ, D_MODEL), f32),
        "positions": positions,
        "pre_mix_norm": gain(ks[2], D_MODEL),
        "w_in": nrm(ks[3], (D_MODEL, D_IN), D_MODEL),
        "q_a_norm": gain(ks[4], Q_LORA),
        "w_uq": nrm(ks[5], (Q_LORA, MLA_HEADS * (NOPE_DIM + ROPE_DIM)), Q_LORA),
        "kv_a_norm": gain(ks[6], KV_LORA),
        "w_ukv": nrm(ks[7], (KV_LORA, MLA_HEADS * (NOPE_DIM + V_DIM)), KV_LORA),
        "b_forget": jax.random.uniform(ks[8], (FOX_HEADS,), f32, 1.0, 4.0),
        "b_gate": 0.02 * jax.random.normal(ks[9], (N_BRANCHES * D_MODEL,), f32),
        "w_branch_mla": nrm(ks[10], (MLA_HEADS * V_DIM, D_MODEL), MLA_HEADS * V_DIM),
        "w_branch_fox": nrm(ks[11], (FOX_HEADS * FOX_HEAD_DIM, D_MODEL), FOX_HEADS * FOX_HEAD_DIM),
        "w_out": nrm(ks[12], (D_MODEL, D_MODEL), D_MODEL),
        "post_mix_norm": gain(ks[13], D_MODEL),
        "pre_ffn_norm": gain(ks[14], D_MODEL),
        "w_up": nrm(ks[15], (D_MODEL, 2 * D_FF), D_MODEL),
        "conv_w": nrm(ks[16], (CONV_WIDTH, 2 * D_FF), CONV_WIDTH),
        "conv_b": 0.02 * jax.random.normal(ks[17], (2 * D_FF,), f32),
        "w_down": nrm(ks[18], (D_FF, D_MODEL), D_FF),
        "post_ffn_norm": gain(ks[19], D_MODEL),
    }


def reference(x, positions, pre_mix_norm, w_in, q_a_norm, w_uq, kv_a_norm, w_ukv,
              b_forget, b_gate, w_branch_mla, w_branch_fox, w_out, post_mix_norm,
              pre_ffn_norm, w_up, conv_w, conv_b, w_down, post_ffn_norm):
    B, S, _ = x.shape
    cos, sin = rope_tables(positions, x.dtype)
    for _layer in range(DEPTH):
        h = rmsnorm(x, pre_mix_norm)
        proj = h @ w_in
        cuts = np.cumsum(SPLITS)[:-1].tolist()
        q_lat, kv_lat, k_pe, fq, fk, fv, f_logit, g_logit = jnp.split(proj, cuts, axis=-1)

        q = (rmsnorm(q_lat, q_a_norm) @ w_uq).reshape(B, S, MLA_HEADS, NOPE_DIM + ROPE_DIM)
        q_nope, q_pe = q[..., :NOPE_DIM], q[..., NOPE_DIM:]
        q_pe = rope(q_pe, cos[:, :, None, :], sin[:, :, None, :])
        kv = (rmsnorm(kv_lat, kv_a_norm) @ w_ukv).reshape(B, S, MLA_HEADS, NOPE_DIM + V_DIM)
        k_nope, v_mla = kv[..., :NOPE_DIM], kv[..., NOPE_DIM:]
        k_pe = rope(k_pe, cos, sin)[:, :, None, :]
        q_mla = jnp.concatenate([q_nope, q_pe], axis=-1)
        k_mla = jnp.concatenate([k_nope, jnp.broadcast_to(k_pe, (B, S, MLA_HEADS, ROPE_DIM))], axis=-1)
        o_mla = block_attention(q_mla, k_mla, v_mla, CHUNK).reshape(B, S, MLA_HEADS * V_DIM)

        log_f = jax.nn.log_sigmoid(f_logit.astype(jnp.float32) + b_forget.astype(jnp.float32))
        c = jnp.transpose(jnp.cumsum(log_f, axis=1), (0, 2, 1))
        shp = (B, S, FOX_HEADS, FOX_HEAD_DIM)
        o_fox = block_attention(fq.reshape(shp), fk.reshape(shp), fv.reshape(shp), 1, c)
        o_fox = o_fox.reshape(B, S, FOX_HEADS * FOX_HEAD_DIM)

        gates = jax.nn.sigmoid((g_logit + b_gate).astype(jnp.float32)).astype(x.dtype)
        g_mla, g_fox = gates[..., :D_MODEL], gates[..., D_MODEL:]
        merged = g_mla * (o_mla @ w_branch_mla) + g_fox * (o_fox @ w_branch_fox)
        x = x + rmsnorm(merged @ w_out, post_mix_norm)

        h2 = rmsnorm(x, pre_ffn_norm)
        u = h2 @ w_up
        u_pad = jnp.pad(u, ((0, 0), (CONV_WIDTH - 1, 0), (0, 0)))
        u = sum(conv_w[j] * u_pad[:, j:j + S] for j in range(CONV_WIDTH)) + conv_b
        gate, val = u[..., :D_FF], u[..., D_FF:]
        ff = (jax.nn.gelu(gate, approximate=True) * val) @ w_down
        x = x + rmsnorm(ff, post_ffn_norm)
    return x
```

```cpp
#include <hip/hip_runtime.h>
#include <hip/hip_cooperative_groups.h>
#include <cstdio>
#include <cstdint>
#include <cmath>
namespace cg = cooperative_groups;

namespace pg8 {
#define PG8_LAS __attribute__((address_space(3)))
typedef unsigned short bf16_t;
typedef short bf16x8 __attribute__((ext_vector_type(8)));
typedef float f32x4 __attribute__((ext_vector_type(4)));
typedef unsigned u32x4 __attribute__((ext_vector_type(4)));
constexpr int BM = 256, BK = 64, HALF = 128, HTB = HALF * BK * 2  , STAGE_BYTES = 8 * HTB, NXCD = 8, WGM = 8;

__host__ __device__ __forceinline__ int lds_byte(int r, int c) { const int st = (r >> 4) * 2 + (c >> 5), rr = r & 15, cc = c & 31, ob = rr * 64 + cc * 2; return st * 1024 + (ob ^ (((ob >> 9) & 1) << 5)); }
__host__ __device__ __forceinline__ void stage_rc(int b, int& R, int& C) { const int st = b / 1024, sb = b % 1024, swz = sb ^ (((sb >> 9) & 1) << 5); R = (st >> 1) * 16 + swz / 64; C = (st & 1) * 32 + (swz % 64) / 2; }
__host__ __device__ __forceinline__ int perm32(int rho) { const int n = rho >> 4, i = rho & 15; return 8 * (i >> 2) + 4 * n + (i & 3); }

struct Unit { int pm, pn; };
struct Gemm { const bf16_t* A; const bf16_t* Bt; int M, N, K; };

struct StaticOrder {
    int nM, nN, nwg, G, c;
    __host__ __device__ void init(int M, int N, int G_, int c_) { nM = M / BM; nN = N / BM; nwg = nM * nN; G = G_; c = c_; }
    __host__ __device__ bool next(int i, Unit& u) const {
        const long L = (long)i * G + c; if (L >= nwg) return false;
        int wgid = (int)L; { const int q = nwg / NXCD, r = nwg % NXCD, xcd = wgid % NXCD, off = wgid / NXCD; wgid = (xcd < r ? xcd * (q + 1) : r * (q + 1) + (xcd - r) * q) + off; }
        const int nig = WGM * nN, gid = wgid / nig, fm = gid * WGM, gsz = (nM - fm) < WGM ? (nM - fm) : WGM;
        u.pm = fm + ((wgid % nig) % gsz); u.pn = (wgid % nig) / gsz; return true;
    }
    __device__ __forceinline__ void a_ready(const Unit&) const {}
    __device__ __forceinline__ void done(const Unit&) const {}
};

__device__ __forceinline__ unsigned cvt_pk_bf16(float lo, float hi) { unsigned r; asm volatile("v_cvt_pk_bf16_f32 %0, %1, %2" : "=v"(r) : "v"(lo), "v"(hi)); return r; }
typedef unsigned u32x4 __attribute__((ext_vector_type(4)));
__device__ __forceinline__ float bf_lo(unsigned w) { return __uint_as_float(w << 16); }
__device__ __forceinline__ float bf_hi(unsigned w) { return __uint_as_float(w & 0xffff0000u); }
__device__ __forceinline__ float fsigmoid(float x) { return __builtin_amdgcn_rcpf(1.0f + __expf(-x)); }
#define GAS1 __attribute__((address_space(1)))
template <int MODE> struct Epi {
    static constexpr bool PERM = true, AFTER_DRAIN = false;
    void* O; int ldc; const float* bias; const bf16_t* G; int ldg; const float* cosT; const float* sinT; int ntile_special; PG8_LAS unsigned char* stg;
    __device__ __forceinline__ void operator()(const f32x4 (&acc)[2][2][4][2], const Unit& u, int wr, int wc, int fr, int fq) const {
        const int row0 = u.pm * BM + wr * 64 + fr, col0 = u.pn * BM + wc * 64 + 8 * fq;
        PG8_LAS unsigned char* sl = stg + (wr * 4 + wc) * 2304; const int L = fq * 16 + fr;
        const unsigned wa = (unsigned)(size_t)(sl + fr * 144 + fq * 16), ra = (unsigned)(size_t)(sl + (L >> 3) * 144 + (L & 7) * 16);
        const bool special = (MODE == 1) ? (u.pn < ntile_special) : (MODE == 2 ? (u.pn >= ntile_special) : false);
        u32x4 rb[2][2];
        bf16_t* obase = (bf16_t*)O + (size_t)(u.pm * BM + wr * 64 + (L >> 3)) * ldc + u.pn * BM + wc * 64 + 8 * (L & 7);
#pragma unroll
        for (int g = 0; g < 8; ++g) {
            const int ai = g >> 2, m = g & 3;
            const int row = row0 + ai * HALF + m * 16;
#pragma unroll
            for (int bj = 0; bj < 2; ++bj) {
                const int col = col0 + bj * 32;
                f32x4 v0 = acc[ai][bj][m][0], v1 = acc[ai][bj][m][1];
                if (MODE == 1) {
                    if (special) {
                        const f32x4 b0 = *(const GAS1 f32x4*)(bias + col) * -1.4426950408889634f, b1 = *(const GAS1 f32x4*)(bias + col + 4) * -1.4426950408889634f;
#pragma unroll
                        for (int j = 0; j < 4; ++j) { v0[j] = __builtin_amdgcn_rcpf(1.0f + __builtin_amdgcn_exp2f(__builtin_fmaf(v0[j], -1.4426950408889634f, b0[j])));
                                                      v1[j] = __builtin_amdgcn_rcpf(1.0f + __builtin_amdgcn_exp2f(__builtin_fmaf(v1[j], -1.4426950408889634f, b1[j]))); }
                    }
                }
                if (MODE == 2) {
                    if (special) {
                        const int fi = ((col & 63) >> 3) * 4;
                        const f32x4 c = *(const GAS1 f32x4*)(cosT + (size_t)row * 32 + fi), s_ = *(const GAS1 f32x4*)(sinT + (size_t)row * 32 + fi);
                        const f32x4 o1 = v0 * c - v1 * s_, o2 = v1 * c + v0 * s_; v0 = o1; v1 = o2;
                    }
                }
                if (MODE == 3 || MODE == 4) {
                    const u32x4 gw = *(const GAS1 u32x4*)(G + (size_t)row * ldg + col);
                    const f32x4 g0 = {bf_lo(gw.x), bf_hi(gw.x), bf_lo(gw.y), bf_hi(gw.y)}, g1 = {bf_lo(gw.z), bf_hi(gw.z), bf_lo(gw.w), bf_hi(gw.w)};
                    v0 = v0 * g0; v1 = v1 * g1;
                    if (MODE == 4) {
                        const u32x4 ow = *(const GAS1 u32x4*)((const bf16_t*)O + (size_t)row * ldc + col);
                        const f32x4 o0 = {bf_lo(ow.x), bf_hi(ow.x), bf_lo(ow.y), bf_hi(ow.y)}, o1 = {bf_lo(ow.z), bf_hi(ow.z), bf_lo(ow.w), bf_hi(ow.w)};
                        v0 += o0; v1 += o1;
                    }
                }
                u32x4 w; w.x = cvt_pk_bf16(v0[0], v0[1]); w.y = cvt_pk_bf16(v0[2], v0[3]); w.z = cvt_pk_bf16(v1[0], v1[1]); w.w = cvt_pk_bf16(v1[2], v1[3]);
                if (bj == 0) asm volatile("ds_write_b128 %0, %1" :: "v"(wa), "v"(w)); else asm volatile("ds_write_b128 %0, %1 offset:64" :: "v"(wa), "v"(w));
            }
            asm volatile("ds_read_b128 %0, %1" : "=&v"(rb[g & 1][0]) : "v"(ra));
            asm volatile("ds_read_b128 %0, %1 offset:1152" : "=&v"(rb[g & 1][1]) : "v"(ra));
            if (g >= 1) {
                asm volatile("s_waitcnt lgkmcnt(4)" : "+v"(rb[(g - 1) & 1][0]), "+v"(rb[(g - 1) & 1][1]));
                bf16_t* ob = obase + (size_t)(((g - 1) >> 2) * HALF + ((g - 1) & 3) * 16) * ldc;
                *(GAS1 u32x4*)ob = rb[(g - 1) & 1][0]; *(GAS1 u32x4*)(ob + (size_t)8 * ldc) = rb[(g - 1) & 1][1];
            }
        }
        asm volatile("s_waitcnt lgkmcnt(0)" : "+v"(rb[1][0]), "+v"(rb[1][1]));
        { bf16_t* ob = obase + (size_t)(HALF + 3 * 16) * ldc; *(GAS1 u32x4*)ob = rb[1][0]; *(GAS1 u32x4*)(ob + (size_t)8 * ldc) = rb[1][1]; }
    }
};


__device__ __forceinline__ float dpp_prev1(float prev, float cur) {
    const int t = __builtin_amdgcn_update_dpp(0, __builtin_bit_cast(int, prev), 0x121, 0xf, 0xf, false);
    return __builtin_bit_cast(float, __builtin_amdgcn_update_dpp(t, __builtin_bit_cast(int, cur), 0x111, 0xf, 0xf, false));
}
__device__ __forceinline__ float dpp_prev2(float prev, float cur) {
    const int t = __builtin_amdgcn_update_dpp(0, __builtin_bit_cast(int, prev), 0x122, 0xf, 0xf, false);
    return __builtin_bit_cast(float, __builtin_amdgcn_update_dpp(t, __builtin_bit_cast(int, cur), 0x112, 0xf, 0xf, false));
}
__device__ __forceinline__ float gelu_tanh_f(float x) {
    const float q = __builtin_fmaf(x * x, -0.10294325f, -2.3022082f);
    return x * __builtin_amdgcn_rcpf(1.0f + __builtin_amdgcn_exp2f(x * q));
}
typedef _Float16 h2_t __attribute__((ext_vector_type(2)));
__device__ __forceinline__ h2_t pkh(float a, float b) { return __builtin_bit_cast(h2_t, __builtin_amdgcn_cvt_pkrtz(a, b)); }
__device__ __forceinline__ h2_t pkh_rn(float a, float b) { h2_t r; r.x = (_Float16)a; r.y = (_Float16)b; return r; }
__device__ __forceinline__ h2_t dpph1(h2_t prev, h2_t cur) {
    const int pi = __builtin_bit_cast(int, prev), t = __builtin_amdgcn_update_dpp(pi, pi, 0x121, 0xf, 0xf, false);
    return __builtin_bit_cast(h2_t, __builtin_amdgcn_update_dpp(t, __builtin_bit_cast(int, cur), 0x111, 0xf, 0xf, false));
}
__device__ __forceinline__ h2_t dpph2(h2_t prev, h2_t cur) {
    const int pi = __builtin_bit_cast(int, prev), t = __builtin_amdgcn_update_dpp(pi, pi, 0x122, 0xf, 0xf, false);
    return __builtin_bit_cast(h2_t, __builtin_amdgcn_update_dpp(t, __builtin_bit_cast(int, cur), 0x112, 0xf, 0xf, false));
}
typedef unsigned u32x2e __attribute__((ext_vector_type(2)));
struct EpiConv {
    static constexpr bool PERM = true, AFTER_DRAIN = false;
    bf16_t* ACT; float* HU; const float* cw; const float* cb; PG8_LAS unsigned char* hl; int nN; int dff;
    __device__ __forceinline__ int hidx(int ai, int wr, int wc, int slot, int bj, int fq, int n) const { return ((((((ai * 2 + wr) * 4 + wc) * 2 + slot) * 2 + bj) * 4 + fq) * 2 + n) * 16; }
    __device__ __forceinline__ void operator()(const f32x4 (&acc)[2][2][4][2], const Unit& u, int wr, int wc, int fr, int fq) const {
        if (fr >= 14) {
#pragma unroll
            for (int ai = 0; ai < 2; ++ai)
#pragma unroll
                for (int bj = 0; bj < 2; ++bj)
#pragma unroll
                    for (int n = 0; n < 2; ++n) *(PG8_LAS f32x4*)(hl + hidx(ai, wr, wc, fr - 14, bj, fq, n)) = acc[ai][bj][3][n];
            if (wr == 1) {
#pragma unroll
                for (int bj = 0; bj < 2; ++bj)
#pragma unroll
                    for (int n = 0; n < 2; ++n) *(f32x4*)(HU + ((size_t)(u.pm * 4 + 2 + (fr - 14)) * nN + u.pn) * 256 + 128 * bj + 32 * wc + 8 * fq + 4 * n) = acc[1][bj][3][n];
            }
        }
        if (fr < 2 && wr == 0) {
#pragma unroll
            for (int bj = 0; bj < 2; ++bj)
#pragma unroll
                for (int n = 0; n < 2; ++n) *(f32x4*)(HU + ((size_t)(u.pm * 4 + fr) * nN + u.pn) * 256 + 128 * bj + 32 * wc + 8 * fq + 4 * n) = acc[0][bj][0][n];
        }
        asm volatile("s_waitcnt lgkmcnt(0)" ::: "memory"); __builtin_amdgcn_s_barrier(); asm volatile("" ::: "memory");
        const int row0 = u.pm * BM + wr * 64 + fr;
        u32x2e res[2][4];
#pragma unroll
        for (int n = 0; n < 2; ++n) {
            const int ch0 = u.pn * 128 + wc * 32 + 8 * fq + 4 * n;
            const f32x4 wg0 = *(const f32x4*)(cw + ch0), wg1 = *(const f32x4*)(cw + 2 * dff + ch0), wg2 = *(const f32x4*)(cw + 4 * dff + ch0);
            const f32x4 wv0 = *(const f32x4*)(cw + dff + ch0), wv1 = *(const f32x4*)(cw + 3 * dff + ch0), wv2 = *(const f32x4*)(cw + 5 * dff + ch0);
            const f32x4 bg = *(const f32x4*)(cb + ch0), bv = *(const f32x4*)(cb + dff + ch0);
            h2_t wg0h[2], wg1h[2], wg2h[2], wv0h[2], wv1h[2], wv2h[2], bgh[2], bvh[2];
#pragma unroll
            for (int p = 0; p < 2; ++p) { wg0h[p] = pkh_rn(wg0[2 * p], wg0[2 * p + 1]); wg1h[p] = pkh_rn(wg1[2 * p], wg1[2 * p + 1]); wg2h[p] = pkh_rn(wg2[2 * p], wg2[2 * p + 1]);
                wv0h[p] = pkh_rn(wv0[2 * p], wv0[2 * p + 1]); wv1h[p] = pkh_rn(wv1[2 * p], wv1[2 * p + 1]); wv2h[p] = pkh_rn(wv2[2 * p], wv2[2 * p + 1]);
                bgh[p] = pkh_rn(bg[2 * p], bg[2 * p + 1]); bvh[p] = pkh_rn(bv[2 * p], bv[2 * p + 1]); }
#pragma unroll
            for (int ai = 0; ai < 2; ++ai) {
                f32x4 pg = {0.f, 0.f, 0.f, 0.f}, pv = pg;
                const bool has = !(ai == 0 && wr == 0);
                if (has && fr >= 14) { const int pai = (wr == 1) ? ai : ai - 1, pwr = (wr == 1) ? 0 : 1;
                    pg = *(const PG8_LAS f32x4*)(hl + hidx(pai, pwr, wc, fr - 14, 0, fq, n)); pv = *(const PG8_LAS f32x4*)(hl + hidx(pai, pwr, wc, fr - 14, 1, fq, n)); }
                h2_t qgh[2] = {pkh(pg[0], pg[1]), pkh(pg[2], pg[3])}, qvh[2] = {pkh(pv[0], pv[1]), pkh(pv[2], pv[3])};
#pragma unroll
                for (int m = 0; m < 4; ++m) {
                    const f32x4 cg = acc[ai][0][m][n], cv = acc[ai][1][m][n];
                    const h2_t cgh[2] = {pkh(cg[0], cg[1]), pkh(cg[2], cg[3])}, cvh[2] = {pkh(cv[0], cv[1]), pkh(cv[2], cv[3])};
                    float o[4];
#pragma unroll
                    for (int p = 0; p < 2; ++p) {
                        const h2_t g1 = dpph1(qgh[p], cgh[p]), g2 = dpph2(qgh[p], cgh[p]);
                        const h2_t v1 = dpph1(qvh[p], cvh[p]), v2 = dpph2(qvh[p], cvh[p]);
                        const h2_t gg = wg2h[p] * cgh[p] + wg1h[p] * g1 + wg0h[p] * g2 + bgh[p];
                        const h2_t vv = wv2h[p] * cvh[p] + wv1h[p] * v1 + wv0h[p] * v2 + bvh[p];
                        const h2_t q = gg * gg * (h2_t){(_Float16)-0.10294325f, (_Float16)-0.10294325f} + (h2_t){(_Float16)-2.3022082f, (_Float16)-2.3022082f};
                        const h2_t arg = gg * q;
                        h2_t ex; ex.x = __builtin_exp2f16(arg.x); ex.y = __builtin_exp2f16(arg.y);
                        const h2_t den = ex + (h2_t){(_Float16)1.0f, (_Float16)1.0f};
                        h2_t rc; rc.x = __builtin_amdgcn_rcph(den.x); rc.y = __builtin_amdgcn_rcph(den.y);
                        const h2_t og = gg * rc * vv;
                        o[2 * p] = (float)og.x; o[2 * p + 1] = (float)og.y;
                        qgh[p] = cgh[p]; qvh[p] = cvh[p];
                    }
                    u32x2e w; w.x = cvt_pk_bf16(o[0], o[1]); w.y = cvt_pk_bf16(o[2], o[3]);
                    if (n == 0) res[ai][m] = w;
                    else { u32x4 w4; w4.x = res[ai][m].x; w4.y = res[ai][m].y; w4.z = w.x; w4.w = w.y;
                           *(u32x4*)(ACT + (size_t)(row0 + ai * HALF + m * 16) * dff + ch0 - 4) = w4; }
                }
            }
        }
    }
};

template <class Epi, class Sched, bool ALIGN_EPI = false, bool SP2 = false>
__device__ __forceinline__ void gemm_phase(PG8_LAS unsigned char* lds, const Gemm g, const Sched& S, const Epi& E) {
    int tid_ = threadIdx.x; asm volatile("" : "+v"(tid_));
    const int tid = tid_, wid = __builtin_amdgcn_readfirstlane(tid >> 6), lane = tid & 63, wr = wid >> 2, wc = wid & 3, fr = lane & 15, fq = lane >> 4;
    const int K = g.K, nt = K / BK;
    unsigned voffA[2], voffB[2];
#pragma unroll
    for (int i = 0; i < 2; ++i) { int R, C; stage_rc(tid * 16 + i * 8192, R, C); const int Rb = Epi::PERM ? (64 * (R >> 5) + perm32(R & 31)) : R;
        voffA[i] = (unsigned)(R * K + C) * 2u; voffB[i] = (unsigned)(Rb * K + C) * 2u; }
    const size_t kstep = (size_t)(BK * 2);
    const size_t hstep = (size_t)HALF * K * 2;
    const size_t hstepB = Epi::PERM ? (size_t)32 * K * 2 : hstep;
    const size_t tstep = 2 * hstep;
    const unsigned ldsw = (unsigned)wid * 1024u;
    const int aoff = lds_byte(wr * 64 + fr, fq * 8), boff = lds_byte(wc * 32 + fr, fq * 8);
#define PG8_SA(b, h) (((b) * 2 + (h)) * HTB)
#define PG8_SB(b, h) ((4 + (b) * 2 + (h)) * HTB)
#define PG8_STAGE(bufoff, gbase, voff) do { _Pragma("unroll") for (int _i = 0; _i < 2; ++_i) \
        __builtin_amdgcn_global_load_lds((const unsigned*)((const char*)(gbase) + (voff)[_i]), (PG8_LAS unsigned*)(lds + (bufoff) + ldsw + _i * 8192), 16, 0, 0); } while (0)
#define PG8_LDA(dst, b, h) do { _Pragma("unroll") for (int m = 0; m < 4; ++m) _Pragma("unroll") for (int k = 0; k < 2; ++k) dst[m][k] = *(const PG8_LAS bf16x8*)(lds + PG8_SA(b, h) + aoff + m * 2048 + k * 1024); } while (0)
#define PG8_LDB(dst, b, h) do { _Pragma("unroll") for (int n = 0; n < 2; ++n) _Pragma("unroll") for (int k = 0; k < 2; ++k) dst[n][k] = *(const PG8_LAS bf16x8*)(lds + PG8_SB(b, h) + boff + n * 2048 + k * 1024); } while (0)
#define PG8_MMA(ai, bj, At, Bt) do { __builtin_amdgcn_s_setprio(1); _Pragma("unroll") for (int m = 0; m < 4; ++m) _Pragma("unroll") for (int n = 0; n < 2; ++n) _Pragma("unroll") for (int k = 0; k < 2; ++k) \
        acc[ai][bj][m][n] = __builtin_amdgcn_mfma_f32_16x16x32_bf16(Bt[n][k], At[m][k], acc[ai][bj][m][n], 0, 0, 0); __builtin_amdgcn_s_setprio(0); } while (0)
#define PG8_WAIT_V(n) asm volatile("s_waitcnt vmcnt(" #n ")" ::: "memory")
#define PG8_WAIT_L(n) asm volatile("s_waitcnt lgkmcnt(" #n ")" ::: "memory")
#define PG8_BAR __builtin_amdgcn_s_barrier()
#define PG8_SCHED __builtin_amdgcn_sched_barrier(0)
    Unit cur, nxt; int ui = 0;
    if (!S.next(0, cur)) return;
    f32x4 acc[2][2][4][2];
#pragma unroll
    for (int a = 0; a < 2; ++a)
#pragma unroll
        for (int b = 0; b < 2; ++b)
#pragma unroll
            for (int m = 0; m < 4; ++m)
#pragma unroll
                for (int n = 0; n < 2; ++n) acc[a][b][m][n] = (f32x4){0.f, 0.f, 0.f, 0.f};
    bf16x8 At[4][2], B0[2][2], B1[2][2];
    const char* cA = (const char*)g.A + (size_t)cur.pm * tstep; const char* cB = (const char*)g.Bt + (size_t)cur.pn * tstep;
    S.a_ready(cur);
    if constexpr (SP2) {
        PG8_STAGE(PG8_SB(0, 0), cB, voffB); PG8_STAGE(PG8_SB(0, 1), cB + hstepB, voffB); PG8_STAGE(PG8_SA(0, 0), cA, voffA); PG8_STAGE(PG8_SA(0, 1), cA + hstep, voffA);
        if (wr == 1) PG8_BAR;
        PG8_WAIT_V(2); PG8_BAR;
        PG8_STAGE(PG8_SB(1, 0), cB + kstep, voffB); PG8_STAGE(PG8_SA(1, 0), cA + kstep, voffA); PG8_STAGE(PG8_SB(1, 1), cB + hstepB + kstep, voffB);
        PG8_WAIT_V(6); PG8_BAR;
    } else {
        PG8_STAGE(PG8_SB(0, 0), cB, voffB); PG8_STAGE(PG8_SA(0, 0), cA, voffA); PG8_STAGE(PG8_SB(0, 1), cB + hstepB, voffB); PG8_STAGE(PG8_SA(0, 1), cA + hstep, voffA);
        if (wr == 1) PG8_BAR;
        PG8_WAIT_V(4); PG8_BAR;
        PG8_STAGE(PG8_SB(1, 0), cB + kstep, voffB); PG8_STAGE(PG8_SA(1, 0), cA + kstep, voffA); PG8_STAGE(PG8_SB(1, 1), cB + hstepB + kstep, voffB);
        PG8_WAIT_V(6); PG8_BAR;
    }
    for (;;) {
        const bool has_next = S.next(ui + 1, nxt);
        const char* nA = has_next ? (const char*)g.A + (size_t)nxt.pm * tstep : cA; const char* nB = has_next ? (const char*)g.Bt + (size_t)nxt.pn * tstep : cB;
        for (int t = 0; t < nt; t += 2) {
            const bool last = (t == nt - 2);
            const char* a1 = cA + (size_t)(t + 1) * kstep;
            const char* a2 = last ? nA : cA + (size_t)(t + 2) * kstep; const char* b2 = last ? nB : cB + (size_t)(t + 2) * kstep;
            const char* a3 = a2 + kstep; const char* b3 = b2 + kstep;
            if (last && has_next) S.a_ready(nxt);
            if constexpr (SP2) {
            PG8_LDB(B0, 0, 0); PG8_LDB(B1, 0, 1); PG8_SCHED; PG8_LDA(At, 0, 0); PG8_STAGE(PG8_SA(1, 1), a1 + hstep, voffA);
            PG8_WAIT_V(8); PG8_WAIT_L(0); PG8_BAR; PG8_MMA(0, 0, At, B0); PG8_MMA(0, 1, At, B1); PG8_BAR; PG8_SCHED;
            PG8_LDA(At, 0, 1); PG8_STAGE(PG8_SB(0, 0), b2, voffB); PG8_STAGE(PG8_SB(0, 1), b2 + hstepB, voffB); PG8_STAGE(PG8_SA(0, 0), a2, voffA);
            PG8_WAIT_V(8); PG8_WAIT_L(0); PG8_BAR; PG8_MMA(1, 0, At, B0); PG8_MMA(1, 1, At, B1); PG8_BAR; PG8_SCHED;
            PG8_LDB(B0, 1, 0); PG8_LDB(B1, 1, 1); PG8_SCHED; PG8_LDA(At, 1, 0); PG8_STAGE(PG8_SA(0, 1), a2 + hstep, voffA);
            PG8_WAIT_V(8); PG8_WAIT_L(0); PG8_BAR; PG8_MMA(0, 0, At, B0); PG8_MMA(0, 1, At, B1); PG8_BAR; PG8_SCHED;
            PG8_LDA(At, 1, 1); PG8_STAGE(PG8_SB(1, 0), b3, voffB); PG8_STAGE(PG8_SB(1, 1), b3 + hstepB, voffB); PG8_STAGE(PG8_SA(1, 0), a3, voffA);
            PG8_WAIT_V(8); PG8_WAIT_L(0); PG8_BAR; PG8_MMA(1, 0, At, B0); PG8_MMA(1, 1, At, B1); PG8_BAR; PG8_SCHED;
            } else {
            PG8_LDB(B0, 0, 0); PG8_SCHED; PG8_LDA(At, 0, 0); PG8_STAGE(PG8_SA(1, 1), a1 + hstep, voffA);
            PG8_WAIT_L(8); PG8_BAR; PG8_WAIT_L(0); PG8_MMA(0, 0, At, B0); PG8_BAR; PG8_SCHED;
            PG8_LDB(B1, 0, 1); PG8_STAGE(PG8_SB(0, 0), b2, voffB);
            PG8_BAR; PG8_WAIT_L(0); PG8_MMA(0, 1, At, B1); PG8_BAR;
            PG8_LDA(At, 0, 1); PG8_STAGE(PG8_SA(0, 0), a2, voffA);
            PG8_BAR; PG8_WAIT_L(0); PG8_MMA(1, 0, At, B0); PG8_BAR; PG8_SCHED;
            PG8_STAGE(PG8_SB(0, 1), b2 + hstepB, voffB);
            PG8_WAIT_V(6); PG8_BAR; PG8_MMA(1, 1, At, B1); PG8_BAR;
            PG8_LDB(B0, 1, 0); PG8_SCHED; PG8_LDA(At, 1, 0); PG8_STAGE(PG8_SA(0, 1), a2 + hstep, voffA);
            PG8_WAIT_L(8); PG8_BAR; PG8_WAIT_L(0); PG8_MMA(0, 0, At, B0); PG8_BAR; PG8_SCHED;
            PG8_LDB(B1, 1, 1); PG8_STAGE(PG8_SB(1, 0), b3, voffB);
            PG8_BAR; PG8_WAIT_L(0); PG8_MMA(0, 1, At, B1); PG8_BAR;
            PG8_LDA(At, 1, 1); PG8_STAGE(PG8_SA(1, 0), a3, voffA);
            PG8_BAR; PG8_WAIT_L(0); PG8_MMA(1, 0, At, B0); PG8_BAR; PG8_SCHED;
            PG8_STAGE(PG8_SB(1, 1), b3 + hstepB, voffB);
            PG8_WAIT_V(6); PG8_BAR; PG8_MMA(1, 1, At, B1); PG8_BAR;
            }
        }
        if constexpr (ALIGN_EPI) { if (wr == 0) PG8_BAR; }
        if constexpr (!Epi::AFTER_DRAIN) { E(acc, cur, wr, wc, fr, fq); S.done(cur); }
        if (!has_next) break;
#pragma unroll
        for (int a = 0; a < 2; ++a)
#pragma unroll
            for (int b = 0; b < 2; ++b)
#pragma unroll
                for (int m = 0; m < 4; ++m)
#pragma unroll
                    for (int n = 0; n < 2; ++n) acc[a][b][m][n] = (f32x4){0.f, 0.f, 0.f, 0.f};
        cur = nxt; cA = nA; cB = nB; ++ui;
        if constexpr (ALIGN_EPI) { if (wr == 1) PG8_BAR; }
    }
    PG8_WAIT_V(0);
    if constexpr (!ALIGN_EPI) { if (wr == 0) PG8_BAR; }
    PG8_BAR;
    if constexpr (Epi::AFTER_DRAIN) { E.fused(acc, cur, wr, wc, fr, fq, lds, wid, lane); S.done(cur); }
#undef PG8_SA
#undef PG8_SB
#undef PG8_STAGE
#undef PG8_LDA
#undef PG8_LDB
#undef PG8_MMA
#undef PG8_WAIT_V
#undef PG8_WAIT_L
#undef PG8_BAR
#undef PG8_SCHED
}
}

#include <type_traits>
#define LAS __attribute__((address_space(3)))
typedef unsigned short bf16_t;
typedef short bf16x8 __attribute__((ext_vector_type(8)));
typedef float f32x4 __attribute__((ext_vector_type(4)));
typedef float f32x16 __attribute__((ext_vector_type(16)));
typedef unsigned u32x4 __attribute__((ext_vector_type(4)));
typedef unsigned u32x2 __attribute__((ext_vector_type(2)));
constexpr int NB = 16, SEQ = 2048, T = NB * SEQ, DM = 2048, NH = 8;
constexpr int DFF = 5632, DFF2 = 2 * DFF;
constexpr int NPROJ = 7168;
constexpr int PC_GATE = 0, PC_FQ = 4096, PC_FK = 5120, PC_QLAT = 6144, PC_KVLAT = 6656, PC_KPE = 6912, PC_FLOG = 6976, PC_END = 6984;
constexpr float EPS = 1e-6f, LOG2E = 1.4426950408889634f;
constexpr int TH = T / 2;

constexpr size_t MiB = 1u << 20;
constexpr size_t WS_WIN = 0, WS_WV = 28 * MiB, WS_WUQ = 32 * MiB, WS_WKN = 34 * MiB, WS_WVM = 35 * MiB, WS_WBM = 36 * MiB, WS_WBF = 40 * MiB, WS_WOUT = 44 * MiB,
                 WS_WUP = 52 * MiB, WS_WDN = 96 * MiB;
constexpr size_t WS_H = 128 * MiB;
constexpr size_t WS_KN = 128 * MiB, WS_VTM = 192 * MiB;
constexpr size_t WS_PROJ = 256 * MiB;
constexpr size_t WS_Y = 256 * MiB;
constexpr size_t WS_ACT = 256 * MiB, WS_FF = 608 * MiB, WS_X1 = 736 * MiB, WS_HU = 864 * MiB;
constexpr size_t WS_VTF = 704 * MiB;
constexpr size_t WS_QN = 768 * MiB, WS_KVN = 800 * MiB, WS_KPE = 816 * MiB, WS_COS = 820 * MiB, WS_SIN = 824 * MiB, WS_CL = 828 * MiB;
constexpr size_t WS_Q = 832 * MiB;
constexpr size_t WS_BAR = 928 * MiB;
constexpr size_t WS_END = 929 * MiB;
constexpr int LDS_BYTES = 159744, LDS_HALO = 131072, LDS_STG = 139264, LDS_MISC = 158720;

__device__ __forceinline__ float wave_sum(float v) {
#pragma unroll
    for (int o = 1; o < 64; o <<= 1) v += __shfl_xor(v, o);
    return v;
}
__device__ __forceinline__ unsigned f2bf(float f) { unsigned u = __builtin_bit_cast(unsigned, f); return (u + 0x7fffu + ((u >> 16) & 1u)) >> 16; }
__device__ __forceinline__ unsigned pk2(float lo, float hi) { return f2bf(lo) | (f2bf(hi) << 16); }
__device__ __forceinline__ float bflo(unsigned w) { return __uint_as_float(w << 16); }
__device__ __forceinline__ float bfhi(unsigned w) { return __uint_as_float(w & 0xffff0000u); }
__device__ __forceinline__ float bf1(bf16_t h) { return __uint_as_float((unsigned)h << 16); }

__device__ __forceinline__ bf16_t* tmap(int mode, int n, bf16_t* d0, bf16_t* d1, int K, float& cs) {
    cs = 1.f;
    if (mode == 0) return d0 + (size_t)n * K;
    if (mode == 4) { const int g = (n >= DFF) ? 1 : 0, c = n - g * DFF; return d0 + (size_t)((c >> 7) * 256 + 64 * ((c & 127) >> 5) + 32 * g + (c & 31)) * K; }
    if (mode == 1) {
        int r;
        if (n < 512) r = PC_QLAT + n;
        else if (n < 768) r = PC_KVLAT + (n - 512);
        else if (n < 832) r = PC_KPE + (n - 768);
        else if (n < 1856) { r = PC_FQ + (n - 832); cs = 0.08838834764831845f * LOG2E; }
        else if (n < 2880) r = PC_FK + (n - 1856);
        else if (n < 3904) return d1 + (size_t)(n - 2880) * K;
        else if (n < 3912) r = PC_FLOG + (n - 3904);
        else r = PC_GATE + (n - 3912);
        return d0 + (size_t)r * K;
    }
    if (mode == 2) {
        cs = 0.07216878364870322f * LOG2E;
        const int hh = n / 192, d = n - hh * 192; int r;
        if (d < 128) r = hh * 128 + d;
        else { const int e = d - 128, i = e & 31, hf = e >> 5; r = 1024 + hh * 64 + 8 * (i >> 2) + 4 * hf + (i & 3); }
        return d0 + (size_t)r * K;
    }
    { const int hh = n >> 8, d = n & 255;
      if (d < 128) return d0 + (size_t)(hh * 128 + d) * K;
      return d1 + (size_t)(hh * 128 + d - 128) * K; }
}
__device__ __forceinline__ void transpose_item(const float* W, int K, int N, int mode, const float* kscale, bf16_t* d0, bf16_t* d1, LAS float* scr, int item, int lane) {
    const int nblk = (N + 31) / 32, kb = item / nblk, nb = item - kb * nblk, k0 = 64 * kb, n0 = 32 * nb;
    const int nn = n0 + (lane & 31); const bool nok = nn < N;
    float tv[32];
#pragma unroll
    for (int i = 0; i < 32; ++i) { const int kk = 2 * i + (lane >> 5); tv[i] = nok ? W[(size_t)(k0 + kk) * N + nn] : 0.f; }
    if (kscale) {
#pragma unroll
        for (int i = 0; i < 32; ++i) tv[i] *= kscale[k0 + 2 * i + (lane >> 5)];
    }
#pragma unroll
    for (int i = 0; i < 32; ++i) { const int kk = 2 * i + (lane >> 5); scr[kk * 33 + (lane & 31)] = tv[i]; }
    asm volatile("s_waitcnt lgkmcnt(0)" ::: "memory");
    const int c = lane & 7;
#pragma unroll
    for (int j = 0; j < 4; ++j) { const int n = (lane >> 3) + 8 * j; const LAS float* s = scr + (8 * c) * 33 + n;
        if (n0 + n < N) { float cs; bf16_t* dst = tmap(mode, n0 + n, d0, d1, K, cs);
            u32x4 o; o.x = pk2(s[0 * 33] * cs, s[1 * 33] * cs); o.y = pk2(s[2 * 33] * cs, s[3 * 33] * cs); o.z = pk2(s[4 * 33] * cs, s[5 * 33] * cs); o.w = pk2(s[6 * 33] * cs, s[7 * 33] * cs);
            *(u32x4*)(dst + k0 + 8 * c) = o; } }
    asm volatile("s_waitcnt lgkmcnt(0)" ::: "memory");
}

__device__ __forceinline__ void rms_row_to_bf16(const float* xrow, const float* g, bf16_t* orow, int lane) {
    const f32x4* xr = (const f32x4*)xrow + lane; const f32x4* gr = (const f32x4*)g + lane;
    f32x4 v[8]; float s = 0.f;
#pragma unroll
    for (int j = 0; j < 8; ++j) { v[j] = xr[64 * j]; s += (v[j].x * v[j].x + v[j].y * v[j].y) + (v[j].z * v[j].z + v[j].w * v[j].w); }
    const float r = rsqrtf(wave_sum(s) * (1.f / DM) + EPS);
    u32x2* o8 = (u32x2*)orow + lane;
#pragma unroll
    for (int j = 0; j < 8; ++j) { const f32x4 gg = gr[64 * j]; u32x2 w; w.x = pk2(v[j].x * r * gg.x, v[j].y * r * gg.y); w.y = pk2(v[j].z * r * gg.z, v[j].w * r * gg.w); o8[64 * j] = w; }
}

__device__ __forceinline__ void sincos_acc(float ang, float& sn, float& cs) {
    const double a = (double)ang;
    const double kq = __builtin_rint(a * 0.63661977236758134308);
    double r = __builtin_fma(-kq, 1.5707963267948966192, a); r = __builtin_fma(-kq, 6.123233995736766036e-17, r);
    const double r2 = r * r;
    const double sp = r * (1.0 + r2 * (-1.0 / 6 + r2 * (1.0 / 120 + r2 * (-1.0 / 5040 + r2 * (1.0 / 362880 + r2 * (-1.0 / 39916800))))));
    const double cp = 1.0 + r2 * (-0.5 + r2 * (1.0 / 24 + r2 * (-1.0 / 720 + r2 * (1.0 / 40320 + r2 * (-1.0 / 3628800 + r2 * (1.0 / 479001600))))));
    const int q = (int)((long long)kq & 3);
    const double s_ = (q & 1) ? cp : sp, c_ = (q & 1) ? sp : cp;
    sn = (float)((q & 2) ? -s_ : s_);
    cs = (float)(((q + 1) & 2) ? -c_ : c_);
}

#define MAX2(a, b) __builtin_amdgcn_fmed3f((a), (b), big_)
struct AttnPtrs { const bf16_t* Q; const bf16_t* PROJ; const bf16_t* KN; const bf16_t* KPE; const bf16_t* VT; const float* CL; bf16_t* O; };
template <bool MLA, bool grpB>
__device__ __forceinline__ void attn_unit_g(LAS unsigned char* lds, const AttnPtrs& P, int b, int h, int qblk) {
    constexpr int D = MLA ? 192 : 128, ND0 = D / 16, KROW = D * 2, KTILE = 64 * KROW, KSLOT = KTILE + 256, VROW = 128, VTILE = 128 * VROW, VBASE = 4 * KSLOT;
    constexpr int KCH = KTILE / 1024, KCH_W = (KCH + 7) / 8;
    int tid_ = threadIdx.x; asm volatile("" : "+v"(tid_));
    const int tid = tid_, lane = tid & 63, wid = __builtin_amdgcn_readfirstlane(tid >> 6), r32 = lane & 31, hi = lane >> 5;
    const int q0 = qblk * 256 + wid * 32;
    const size_t tokb = (size_t)b * SEQ;
    const int ntile = 4 * qblk + 4, my_last = q0 >> 6;
    bf16x8 qf[ND0];
    if (MLA) {
        const bf16_t* qrow = P.Q + (tokb + q0 + r32) * 1536;
#pragma unroll
        for (int d0 = 0; d0 < 8; ++d0) qf[d0] = *(const bf16x8*)(qrow + h * 128 + 16 * d0 + 8 * hi);
#pragma unroll
        for (int d0 = 8; d0 < ND0; ++d0) qf[d0] = *(const bf16x8*)(qrow + 1024 + h * 64 + 16 * (d0 - 8) + 8 * hi);
    } else {
        const bf16_t* qrow = P.PROJ + (tokb + q0 + r32) * NPROJ + PC_FQ + h * 128;
#pragma unroll
        for (int d0 = 0; d0 < ND0; ++d0) qf[d0] = *(const bf16x8*)(qrow + 16 * d0 + 8 * hi);
    }
    const float* clrow = P.CL + ((size_t)b * NH + h) * SEQ;
    const unsigned char* ksrc[KCH_W]; bool kok[KCH_W];
#pragma unroll
    for (int i = 0; i < KCH_W; ++i) {
        const int c = wid + 8 * i, s = c * 64 + lane; kok[i] = (c < KCH);
        if (MLA) { const int row = s / 24, sl = s - row * 24, g = ((row >> 1) & 3) | (((row >> 4) & 1) << 2), seg = (sl & 24) | ((sl ^ g) & 7);
            ksrc[i] = (seg < 16) ? (const unsigned char*)(P.KN + (tokb + row) * 1024 + h * 128 + seg * 8) : (const unsigned char*)(P.KPE + (tokb + row) * 64 + (seg - 16) * 8); }
        else { const int row = s >> 4, sl = s & 15, f = (row & 7) | (((row >> 4) & 1) << 3), seg = sl ^ f;
            ksrc[i] = (const unsigned char*)(P.PROJ + (tokb + row) * NPROJ + PC_FK + h * 128 + seg * 8); }
    }
    const unsigned char* vsrc[2];
#pragma unroll
    for (int i = 0; i < 2; ++i) { const int c = wid + 8 * i, s = c * 64 + lane, row = s >> 3, sl = s & 7, seg = sl ^ ((row >> 1) & 7);
        vsrc[i] = (const unsigned char*)(P.VT + (size_t)(h * 128 + row) * T + tokb + seg * 8); }
    const size_t kstep = MLA ? 0 : 0; (void)kstep;
    auto dma_k = [&](int j, int koff) {
#pragma unroll
        for (int i = 0; i < KCH_W; ++i) if (kok[i]) {
            size_t adv;
            if (MLA) { const int c = wid + 8 * i, s = c * 64 + lane, row = s / 24, sl = s - row * 24, g = ((row >> 1) & 3) | (((row >> 4) & 1) << 2), seg = (sl & 24) | ((sl ^ g) & 7);
                adv = (seg < 16) ? (size_t)64 * j * 1024 * 2 : (size_t)64 * j * 64 * 2; }
            else adv = (size_t)64 * j * NPROJ * 2;
            __builtin_amdgcn_global_load_lds((const unsigned*)(ksrc[i] + adv), (LAS unsigned*)(lds + koff + (wid + 8 * i) * 1024), 16, 0, 0); }
        if (!MLA) { if (wid == 7 && lane < 16) __builtin_amdgcn_global_load_lds((const unsigned*)(clrow + 64 * j + 4 * lane), (LAS unsigned*)(lds + koff + KTILE), 16, 0, 0); }
    };
    auto dma_v = [&](int j, int voff) {
#pragma unroll
        for (int i = 0; i < 2; ++i) __builtin_amdgcn_global_load_lds((const unsigned*)(vsrc[i] + (size_t)64 * j * 2), (LAS unsigned*)(lds + VBASE + voff + (wid + 8 * i) * 1024), 16, 0, 0);
    };
    f32x16 o[4];
#pragma unroll
    for (int i = 0; i < 4; ++i)
#pragma unroll
        for (int r = 0; r < 16; ++r) o[i][r] = 0.f;
    float lrun = 0.f;
    const int keyrow = 16 * ((r32 >> 2) & 1) + (r32 & 3) + 4 * (r32 >> 3);
    const int kswz = MLA ? (((keyrow >> 1) & 3) | (((keyrow >> 4) & 1) << 2)) : ((keyrow & 7) | (((keyrow >> 4) & 1) << 3));
    const int karow = keyrow * KROW;
    const int vswz = (r32 >> 1) & 7;
    const int varow = VBASE + r32 * VROW;
    f32x16 sc[2];
    bf16x8 pb[2][2];
    constexpr int PFD = 6;
    auto qk = [&](int koff) {
        if (MLA) {
        } else {
#pragma unroll
            for (int blk = 0; blk < 2; ++blk)
#pragma unroll
                for (int g = 0; g < 4; ++g) { const f32x4 c4 = *(const LAS f32x4*)(lds + koff + KTILE + (32 * blk + 16 * hi + 4 * g) * 4);
#pragma unroll
                    for (int e = 0; e < 4; ++e) sc[blk][4 * g + e] = c4[e]; }
        }
        const LAS unsigned char* ka = lds + koff + karow;
        bf16x8 a[PFD];
        auto ld = [&](int i) -> bf16x8 {
            const int d0 = i >> 1, blk = i & 1, seg = 2 * d0;
            int so;
            if (MLA) so = (((seg + hi) & 24) | (((seg + hi) ^ kswz) & 7)) * 16; else so = ((seg + hi) ^ kswz) * 16;
            return *(const LAS bf16x8*)(ka + blk * 32 * KROW + so);
        };
#pragma unroll
        for (int i = 0; i < PFD; ++i) a[i] = ld(i);
#pragma unroll
        for (int i = 0; i < 2 * ND0; ++i) {
            const f32x16 zc = {0.f, 0.f, 0.f, 0.f, 0.f, 0.f, 0.f, 0.f, 0.f, 0.f, 0.f, 0.f, 0.f, 0.f, 0.f, 0.f};
            sc[i & 1] = __builtin_amdgcn_mfma_f32_32x32x16_bf16(a[i % PFD], qf[i >> 1], (MLA && i < 2) ? zc : sc[i & 1], 0, 0, 0);
            if (i + PFD < 2 * ND0) a[i % PFD] = ld(i + PFD);
        }
        __builtin_amdgcn_sched_group_barrier(0x100, PFD, 0);
#pragma unroll
        for (int i = 0; i < 2 * ND0; ++i) { __builtin_amdgcn_sched_group_barrier(0x008, 1, 0); __builtin_amdgcn_sched_group_barrier(0x100, 1, 0); }
        __builtin_amdgcn_sched_barrier(0);
    };
    float mref = -1e30f;
    auto sm = [&](int j) {
        if (j >= my_last) {
            if (MLA) { if (j > my_last) {
#pragma unroll
                for (int r = 0; r < 16; ++r) { sc[0][r] = -2e30f; sc[1][r] = -2e30f; } } }
            else { const int qpos = q0 + r32;
#pragma unroll
                for (int blk = 0; blk < 2; ++blk)
#pragma unroll
                    for (int r = 0; r < 16; ++r) { const int key = 64 * j + 32 * blk + 16 * hi + r; if (key > qpos) sc[blk][r] = -2e30f; } }
        }
        float big_ = 3.0e38f; asm volatile("" : "+v"(big_));
        float mxa = MAX2(sc[0][0], sc[0][1]), mxb = MAX2(sc[0][2], sc[0][3]), mxc = MAX2(sc[1][0], sc[1][1]), mxd = MAX2(sc[1][2], sc[1][3]);
#pragma unroll
        for (int r = 4; r < 16; r += 4) { mxa = MAX2(mxa, MAX2(sc[0][r], sc[0][r + 1])); mxb = MAX2(mxb, MAX2(sc[0][r + 2], sc[0][r + 3])); mxc = MAX2(mxc, MAX2(sc[1][r], sc[1][r + 1])); mxd = MAX2(mxd, MAX2(sc[1][r + 2], sc[1][r + 3])); }
        float mx = MAX2(MAX2(mxa, mxb), MAX2(mxc, mxd));
        mx = MAX2(mx, __shfl_xor(mx, 32));
        if (__any(mx > mref + 8.0f)) {
            const float mnew = fmaxf(mref, mx), f = __builtin_amdgcn_exp2f(mref - mnew);
            mref = mnew; lrun *= f;
#pragma unroll
            for (int i = 0; i < 4; ++i)
#pragma unroll
                for (int r = 0; r < 16; ++r) o[i][r] *= f;
        }
        float ps = 0.f;
#pragma unroll
        for (int blk = 0; blk < 2; ++blk)
#pragma unroll
            for (int r = 0; r < 16; ++r) { const float pv_ = __builtin_amdgcn_exp2f(sc[blk][r] - mref); sc[blk][r] = pv_; ps += pv_; }
        lrun += ps;
#pragma unroll
        for (int blk = 0; blk < 2; ++blk)
#pragma unroll
            for (int ks = 0; ks < 2; ++ks) { u32x4 w;
                w.x = pg8::cvt_pk_bf16(sc[blk][8 * ks + 0], sc[blk][8 * ks + 1]); w.y = pg8::cvt_pk_bf16(sc[blk][8 * ks + 2], sc[blk][8 * ks + 3]);
                w.z = pg8::cvt_pk_bf16(sc[blk][8 * ks + 4], sc[blk][8 * ks + 5]); w.w = pg8::cvt_pk_bf16(sc[blk][8 * ks + 6], sc[blk][8 * ks + 7]);
                pb[blk][ks] = __builtin_bit_cast(bf16x8, w); }
        __builtin_amdgcn_sched_barrier(0);
    };
    auto pv = [&](int voff) {
        const LAS unsigned char* va = lds + varow + voff;
        bf16x8 a[PFD];
        auto ld = [&](int i) -> bf16x8 {
            const int dvb = i & 3, bk = i >> 2, so = ((4 * (bk >> 1) + 2 * hi + (bk & 1)) ^ vswz) * 16;
            return *(const LAS bf16x8*)(va + 32 * dvb * VROW + so);
        };
#pragma unroll
        for (int i = 0; i < PFD; ++i) a[i] = ld(i);
#pragma unroll
        for (int i = 0; i < 16; ++i) {
            o[i & 3] = __builtin_amdgcn_mfma_f32_32x32x16_bf16(a[i % PFD], pb[i >> 3][(i >> 2) & 1], o[i & 3], 0, 0, 0);
            if (i + PFD < 16) a[i % PFD] = ld(i + PFD);
        }
        __builtin_amdgcn_sched_group_barrier(0x100, PFD, 0);
#pragma unroll
        for (int i = 0; i < 16; ++i) { __builtin_amdgcn_sched_group_barrier(0x008, 1, 0); __builtin_amdgcn_sched_group_barrier(0x100, 1, 0); }
        __builtin_amdgcn_sched_barrier(0);
    };
    int k0 = 0, knext = KSLOT, k2 = 2 * KSLOT, k3 = 3 * KSLOT, vcur = 0, v1 = VTILE, v2 = 2 * VTILE;
    const int jl = ntile - 1;
    dma_k(jl, 0); dma_v(jl, 0); dma_k(jl - 1, KSLOT);
    dma_k(jl - 2, 2 * KSLOT); dma_v(jl - 1, VTILE);
    if (MLA) asm volatile("s_waitcnt vmcnt(5)\n\ts_barrier" ::: "memory"); else asm volatile("s_waitcnt vmcnt(4)\n\ts_barrier" ::: "memory");
    if (grpB) qk(0);
    for (int j = jl; j >= 0; --j) {
        if (j >= 3) dma_k(j - 3, k3);
        if (j >= 2) dma_v(j - 2, v2);
        if (!grpB) { if (j <= my_last) { qk(k0); sm(j); pv(vcur); } }
        else { if (j <= my_last) { sm(j); pv(vcur); } if (j > 0 && j - 1 <= my_last) qk(knext); }
        if (j >= 3) { if (MLA) asm volatile("s_waitcnt vmcnt(5) lgkmcnt(0)\n\ts_barrier" ::: "memory"); else asm volatile("s_waitcnt vmcnt(4) lgkmcnt(0)\n\ts_barrier" ::: "memory"); }
        else if (j == 2) asm volatile("s_waitcnt vmcnt(2) lgkmcnt(0)\n\ts_barrier" ::: "memory");
        else asm volatile("s_waitcnt vmcnt(0) lgkmcnt(0)\n\ts_barrier" ::: "memory");
        { const int t = k0; k0 = knext; knext = k2; k2 = k3; k3 = t; const int tv = vcur; vcur = v1; v1 = v2; v2 = tv; }
    }
    const float ltot = lrun + __shfl_xor(lrun, 32);
    const float inv = 1.0f / ltot;
    bf16_t* orow = P.O + (tokb + q0 + r32) * 1024 + h * 128;
#pragma unroll
    for (int dvb = 0; dvb < 4; ++dvb)
#pragma unroll
        for (int g = 0; g < 4; ++g) { u32x2 w; w.x = pg8::cvt_pk_bf16(o[dvb][4 * g] * inv, o[dvb][4 * g + 1] * inv); w.y = pg8::cvt_pk_bf16(o[dvb][4 * g + 2] * inv, o[dvb][4 * g + 3] * inv);
            *(u32x2*)(orow + 32 * dvb + 8 * g + 4 * hi) = w; }
}
template <bool MLA>
__device__ __forceinline__ void attn_unit(LAS unsigned char* lds, const AttnPtrs& P, int b, int h, int qblk) {
    if (__builtin_amdgcn_readfirstlane(threadIdx.x >> 6) < 4) attn_unit_g<MLA, false>(lds, P, b, h, qblk);
    else attn_unit_g<MLA, true>(lds, P, b, h, qblk);
}

#define XB_TMO      128
#define XB_XCNT(j)  (256  + 64 * (j))
#define XB_XSUB(j)  (1280 + 64 * (j))
#define XB_XGEN(j)  (2304 + 64 * (j))
#define XB_TOP      3328
#define XB_TOPGEN   3392
#define XCD_BAR_WORDS 3456
#define XB_SPIN_CAP (1u << 18)

__device__ __forceinline__ unsigned xb_ld(unsigned* p)              { return __hip_atomic_load(p, __ATOMIC_RELAXED, __HIP_MEMORY_SCOPE_AGENT); }
__device__ __forceinline__ unsigned xb_add(unsigned* p, unsigned v) { return __hip_atomic_fetch_add(p, v, __ATOMIC_RELAXED, __HIP_MEMORY_SCOPE_AGENT); }
__device__ __forceinline__ unsigned xb_xcc_id() { return (unsigned)__builtin_amdgcn_s_getreg((3 << 11) | 20) & 0xFu; }
#define XB_SPIN(cond, bar) do { unsigned _sp = 0; while (cond) { __builtin_amdgcn_s_sleep(1); \
    if ((++_sp & 255u) == 0u) { if (xb_ld(&(bar)[XB_TMO])) break; if (_sp > XB_SPIN_CAP) { atomicAdd(&(bar)[XB_TMO], 1u); break; } } } } while (0)

struct XcdBarrier {
    unsigned* bar; unsigned x;
    volatile LAS unsigned* st;
};

__device__ __forceinline__ XcdBarrier xcd_barrier_post(unsigned* bar, volatile LAS unsigned* st) {
    XcdBarrier b; b.bar = bar; b.x = xb_xcc_id(); b.st = st;
    if (threadIdx.x == 0) (void)xb_add(&bar[XB_XCNT(b.x)], 1u);
    return b;
}
__device__ __forceinline__ void xcd_barrier_complete(unsigned* bar, unsigned x, unsigned& nloc, unsigned& nx) {
    const unsigned G = gridDim.x * gridDim.y * gridDim.z;
    unsigned sum, cnt, mine, sp = 0u;
    for (;;) {
        sum = 0u; cnt = 0u; mine = 0u;
#pragma unroll
        for (unsigned j = 0; j < 16; ++j) { const unsigned c = xb_ld(&bar[XB_XCNT(j)]); sum += c; cnt += (c > 0u) ? 1u : 0u; mine = (j == x) ? c : mine; }
        if (sum == G) break;
        __builtin_amdgcn_s_sleep(1);
        if ((++sp & 255u) == 0u) { if (xb_ld(&bar[XB_TMO])) break; if (sp > XB_SPIN_CAP) { atomicAdd(&bar[XB_TMO], 1u); break; } }
    }
    nloc = mine > 0u ? mine : 1u; nx = cnt > 0u ? cnt : 1u;
}

__device__ __forceinline__ void xcd_barrier(const XcdBarrier& b) {
    asm volatile("s_waitcnt vmcnt(0)" ::: "memory");
    __syncthreads();
    if (threadIdx.x == 0) {
        unsigned* bar = b.bar;
        __builtin_amdgcn_s_waitcnt(0);
        unsigned nloc = b.st[0], nx = b.st[1];
        if (nloc == 0u) { xcd_barrier_complete(bar, b.x, nloc, nx); b.st[0] = nloc; b.st[1] = nx; }
        const unsigned old = xb_add(&bar[XB_XSUB(b.x)], 1u);
        const unsigned gen = old / nloc;
        if (old + 1u == (gen + 1u) * nloc) {
            __builtin_amdgcn_fence(__ATOMIC_RELEASE, "agent");
            asm volatile("s_waitcnt vmcnt(0)" ::: "memory");
            const unsigned og = xb_add(&bar[XB_TOP], 1u);
            const unsigned tg = og / nx;
            if (og + 1u == (tg + 1u) * nx) xb_add(&bar[XB_TOPGEN], 1u);
            else XB_SPIN(xb_ld(&bar[XB_TOPGEN]) == tg, bar);
            __builtin_amdgcn_fence(__ATOMIC_ACQUIRE, "agent");
            xb_add(&bar[XB_XGEN(b.x)], 1u);
            asm volatile("s_waitcnt vmcnt(0)" ::: "memory");
        } else {
            XB_SPIN(xb_ld(&bar[XB_XGEN(b.x)]) == gen, bar);
            __builtin_amdgcn_fence(__ATOMIC_ACQUIRE, "agent");
            asm volatile("s_waitcnt vmcnt(0)" ::: "memory");
        }
    }
    __syncthreads();
}


#ifndef MLA_REPS
#define MLA_REPS 1
#endif
#ifndef FOX_REPS
#define FOX_REPS 1
#endif
#ifndef ATTN_REPS
#define ATTN_REPS 1
#endif
#ifndef UP_REPS
#define UP_REPS 1
#endif
struct Args { const float* in[20]; float* out; unsigned char* ws; float inv_freq[32]; };
enum { I_X = 0, I_POS, I_PRE_MIX, I_WIN, I_QAN, I_WUQ, I_KVAN, I_WUKV, I_BFORGET, I_BGATE, I_WBM, I_WBF, I_WOUT, I_POST_MIX, I_PRE_FFN, I_WUP, I_CONVW, I_CONVB, I_WDOWN, I_POST_FFN };

__device__ __forceinline__ float gelu_tanh(float x) {
    const float z = 0.7978845608028654f * (x + 0.044715f * x * x * x);
    return x * __builtin_amdgcn_rcpf(1.0f + __expf(-2.0f * z));
}

#define PTRS() \
    unsigned char* ws = a.ws; float* outp = a.out; asm volatile("" : "+s"(ws), "+s"(outp)); \
    const float* x = a.in[I_X]; (void)x; \
    bf16_t* Win_t = (bf16_t*)(ws + WS_WIN); bf16_t* Wv_t = (bf16_t*)(ws + WS_WV); bf16_t* Wuq_t = (bf16_t*)(ws + WS_WUQ); bf16_t* Wkn_t = (bf16_t*)(ws + WS_WKN); \
    bf16_t* Wvm_t = (bf16_t*)(ws + WS_WVM); bf16_t* Wbm_t = (bf16_t*)(ws + WS_WBM); bf16_t* Wbf_t = (bf16_t*)(ws + WS_WBF); bf16_t* Wout_t = (bf16_t*)(ws + WS_WOUT); \
    bf16_t* Wup_t = (bf16_t*)(ws + WS_WUP); bf16_t* Wdn_t = (bf16_t*)(ws + WS_WDN); \
    bf16_t* H = (bf16_t*)(ws + WS_H); bf16_t* PROJ = (bf16_t*)(ws + WS_PROJ); bf16_t* VTF = (bf16_t*)(ws + WS_VTF); \
    bf16_t* QN = (bf16_t*)(ws + WS_QN); bf16_t* KVN = (bf16_t*)(ws + WS_KVN); bf16_t* KPE = (bf16_t*)(ws + WS_KPE); \
    float* COS = (float*)(ws + WS_COS); float* SIN = (float*)(ws + WS_SIN); float* CL = (float*)(ws + WS_CL); \
    bf16_t* Q = (bf16_t*)(ws + WS_Q); bf16_t* KN = (bf16_t*)(ws + WS_KN); bf16_t* VTM = (bf16_t*)(ws + WS_VTM); \
    bf16_t* OM = (bf16_t*)outp; bf16_t* OF = (bf16_t*)((unsigned char*)outp + 64 * MiB); bf16_t* MERGED = (bf16_t*)((unsigned char*)outp + 128 * MiB); \
    bf16_t* Y = (bf16_t*)(ws + WS_Y); bf16_t* X1 = (bf16_t*)(ws + WS_X1); float* OUT = outp; \
    bf16_t* ACT = (bf16_t*)(ws + WS_ACT); bf16_t* FF = (bf16_t*)(ws + WS_FF); float* HU = (float*)(ws + WS_HU);

__global__ void __launch_bounds__(512, 2) mega_fwd(Args a) {
    extern __shared__ __attribute__((aligned(16))) unsigned char lds_raw[];
    LAS unsigned char* lds = (LAS unsigned char*)lds_raw;
    cg::grid_group grid = cg::this_grid();
    const int tid = threadIdx.x, lane = tid & 63, wave = __builtin_amdgcn_readfirstlane(tid >> 6);
    const int G = gridDim.x, bx = blockIdx.x;
    const int gw = bx * 8 + wave, NGW = G * 8;
    if (tid < 2) ((volatile LAS unsigned*)(lds + LDS_MISC))[tid] = 0u;
    __syncthreads();
    const XcdBarrier xbar = xcd_barrier_post((unsigned*)(a.ws + WS_BAR), (volatile LAS unsigned*)(lds + LDS_MISC));
    if (a.ws == nullptr) grid.sync();
    { PTRS();
    {
        LAS float* scr = (LAS float*)(lds + wave * 16384);
        constexpr int I0 = 251 * 32, I1 = 48 * 8, I2 = 64 * 4, I3 = 64 * 16, I4 = 64 * 16, I5 = 64 * 32, I6 = 352 * 32, I7 = 64 * 88;
        constexpr int NIT = I0 + I1 + I2 + I3 + I4 + I5 + I6 + I7;
        for (int it = gw; it < NIT; it += NGW) {
            int r = it;
            if (r < I0) { transpose_item(a.in[I_WIN], 2048, 8008, 1, nullptr, Win_t, Wv_t, scr, r, lane); continue; } r -= I0;
            if (r < I1) { transpose_item(a.in[I_WUQ], 512, 1536, 2, a.in[I_QAN], Wuq_t, nullptr, scr, r, lane); continue; } r -= I1;
            if (r < I2) { transpose_item(a.in[I_WUKV], 256, 2048, 3, a.in[I_KVAN], Wkn_t, Wvm_t, scr, r, lane); continue; } r -= I2;
            if (r < I3) { transpose_item(a.in[I_WBM], 1024, 2048, 0, nullptr, Wbm_t, nullptr, scr, r, lane); continue; } r -= I3;
            if (r < I4) { transpose_item(a.in[I_WBF], 1024, 2048, 0, nullptr, Wbf_t, nullptr, scr, r, lane); continue; } r -= I4;
            if (r < I5) { transpose_item(a.in[I_WOUT], 2048, 2048, 0, nullptr, Wout_t, nullptr, scr, r, lane); continue; } r -= I5;
            if (r < I6) { transpose_item(a.in[I_WUP], 2048, DFF2, 4, nullptr, Wup_t, nullptr, scr, r, lane); continue; } r -= I6;
            transpose_item(a.in[I_WDOWN], DFF, 2048, 0, nullptr, Wdn_t, nullptr, scr, r, lane);
        }
        { u32x4* z = (u32x4*)(Win_t + (size_t)PC_END * 2048); const int nz = (NPROJ - PC_END) * 2048 / 8;
          for (int i = bx * 512 + tid; i < nz; i += G * 512) z[i] = (u32x4){0u, 0u, 0u, 0u}; }
        for (int m0 = gw * 2; m0 < T; m0 += NGW * 2) {
            f32x4 xv[2][8]; const f32x4* gr = (const f32x4*)a.in[I_PRE_MIX] + lane;
#pragma unroll
            for (int u = 0; u < 2; ++u) { const f32x4* xr = (const f32x4*)(x + (size_t)(m0 + u) * DM) + lane;
#pragma unroll
                for (int j = 0; j < 8; ++j) xv[u][j] = xr[64 * j]; }
#pragma unroll
            for (int u = 0; u < 2; ++u) { float s = 0.f;
#pragma unroll
                for (int j = 0; j < 8; ++j) { const f32x4 v = xv[u][j]; s += (v.x * v.x + v.y * v.y) + (v.z * v.z + v.w * v.w); }
                const float r = rsqrtf(wave_sum(s) * (1.f / DM) + EPS);
                u32x2* o8 = (u32x2*)(H + (size_t)(m0 + u) * DM) + lane;
#pragma unroll
                for (int j = 0; j < 8; ++j) { const f32x4 v = xv[u][j], gg = gr[64 * j]; u32x2 w; w.x = pk2(v.x * r * gg.x, v.y * r * gg.y); w.y = pk2(v.z * r * gg.z, v.w * r * gg.w); o8[64 * j] = w; }
            }
        }
        const int* pos = (const int*)a.in[I_POS];
        for (int i = bx * 512 + tid; i < T * 32; i += G * 512) { const int tk = i >> 5, fi = i & 31; const float ang = (float)pos[tk] * a.inv_freq[fi]; float sn, cs; sincos_acc(ang, sn, cs); COS[i] = cs; SIN[i] = sn; }
    }
    }
    xcd_barrier(xbar);


    { PTRS();
    {
        pg8::Gemm g{H, Win_t, T, NPROJ, DM}; pg8::StaticOrder S; S.init(T, NPROJ, G, bx);
        pg8::Epi<1> E{PROJ, NPROJ, a.in[I_BGATE], nullptr, 0, nullptr, nullptr, 16, lds + LDS_STG};
        pg8::gemm_phase<pg8::Epi<1>, pg8::StaticOrder, true, true>(lds, g, S, E);
    }
    {
        pg8::Gemm g{Wv_t, H, 1024, T, DM}; pg8::StaticOrder S; S.init(1024, T, G, bx);
        pg8::Epi<0> E{VTF, T, nullptr, nullptr, 0, nullptr, nullptr, 0, lds + LDS_STG};
        pg8::gemm_phase<pg8::Epi<0>, pg8::StaticOrder, true, true>(lds, g, S, E);
    }
    }
    xcd_barrier(xbar);

    { PTRS();
    for (int m0 = gw * 4; m0 < T; m0 += NGW * 4) {
        u32x4 wq[4]; u32x2 wk[4]; float k1[4], k2[4], cc[4], ss[4];
#pragma unroll
        for (int u = 0; u < 4; ++u) { const bf16_t* pr = PROJ + (size_t)(m0 + u) * NPROJ;
            wq[u] = *(const u32x4*)(pr + PC_QLAT + 8 * lane); wk[u] = *(const u32x2*)(pr + PC_KVLAT + 4 * lane);
            k1[u] = bf1(pr[PC_KPE + (lane & 31)]); k2[u] = bf1(pr[PC_KPE + 32 + (lane & 31)]); cc[u] = COS[(size_t)(m0 + u) * 32 + (lane & 31)]; ss[u] = SIN[(size_t)(m0 + u) * 32 + (lane & 31)]; }
#pragma unroll
        for (int u = 0; u < 4; ++u) { const int m = m0 + u;
            { const u32x4 w = wq[u];
              float v[8] = {bflo(w.x), bfhi(w.x), bflo(w.y), bfhi(w.y), bflo(w.z), bfhi(w.z), bflo(w.w), bfhi(w.w)}; float s = 0.f;
#pragma unroll
              for (int j = 0; j < 8; ++j) s += v[j] * v[j];
              const float r = rsqrtf(wave_sum(s) * (1.f / 512) + EPS);
              u32x4 o; o.x = pk2(v[0] * r, v[1] * r); o.y = pk2(v[2] * r, v[3] * r); o.z = pk2(v[4] * r, v[5] * r); o.w = pk2(v[6] * r, v[7] * r);
              *(u32x4*)(QN + (size_t)m * 512 + 8 * lane) = o; }
            { const u32x2 w = wk[u];
              float v[4] = {bflo(w.x), bfhi(w.x), bflo(w.y), bfhi(w.y)}; float s = (v[0] * v[0] + v[1] * v[1]) + (v[2] * v[2] + v[3] * v[3]);
              const float r = rsqrtf(wave_sum(s) * (1.f / 256) + EPS);
              u32x2 o; o.x = pk2(v[0] * r, v[1] * r); o.y = pk2(v[2] * r, v[3] * r);
              *(u32x2*)(KVN + (size_t)m * 256 + 4 * lane) = o; }
            if (lane < 32) { const int p1 = 8 * (lane >> 2) + (lane & 3);
              KPE[(size_t)m * 64 + p1] = (bf16_t)f2bf(k1[u] * cc[u] - k2[u] * ss[u]); KPE[(size_t)m * 64 + p1 + 4] = (bf16_t)f2bf(k2[u] * cc[u] + k1[u] * ss[u]); }
        }
    }
#ifndef NO_SCAN
    for (int bh = bx; bh < NB * NH; bh += G) {
        const int b = bh >> 3, hh = bh & 7; const float bfg = a.in[I_BFORGET][hh];
        const int p0 = 256 * wave + 4 * lane;
        float lf[4]; float run = 0.f;
#pragma unroll
        for (int i = 0; i < 4; ++i) { const float f = bf1(PROJ[((size_t)b * SEQ + p0 + i) * NPROJ + PC_FLOG + hh]) + bfg; run += -logf(1.0f + expf(-f)); lf[i] = run; }
        float incl = run;
#pragma unroll
        for (int o = 1; o < 64; o <<= 1) { const float t = __shfl_up(incl, o); if (lane >= o) incl += t; }
        LAS float* tot = (LAS float*)lds;
        if (lane == 63) tot[wave] = incl;
        __syncthreads();
        float base = incl - run;
#pragma unroll
        for (int w = 0; w < 8; ++w) { const float tw = tot[w]; if (w < wave) base += tw; }
        f32x4 o4;
#pragma unroll
        for (int i = 0; i < 4; ++i) o4[i] = -(base + lf[i]) * LOG2E;
        *(f32x4*)(CL + (size_t)bh * SEQ + p0) = o4;
        __syncthreads();
    }
#endif
    }
    xcd_barrier(xbar);

    { PTRS();
    {
        pg8::Gemm g{QN, Wuq_t, T, 1536, 512}; pg8::StaticOrder S; S.init(T, 1536, G, bx);
        pg8::Epi<2> E{Q, 1536, nullptr, nullptr, 0, COS, SIN, 4, lds + LDS_STG};
        pg8::gemm_phase<pg8::Epi<2>, pg8::StaticOrder, true, true>(lds, g, S, E);
    }
    {
        pg8::Gemm g{KVN, Wkn_t, T, 1024, 256}; pg8::StaticOrder S; S.init(T, 1024, G, bx);
        pg8::Epi<0> E{KN, 1024, nullptr, nullptr, 0, nullptr, nullptr, 0, lds + LDS_STG};
        pg8::gemm_phase<pg8::Epi<0>, pg8::StaticOrder, true, true>(lds, g, S, E);
    }
    {
        pg8::Gemm g{Wvm_t, KVN, 1024, T, 256}; pg8::StaticOrder S; S.init(1024, T, G, bx);
        pg8::Epi<0> E{VTM, T, nullptr, nullptr, 0, nullptr, nullptr, 0, lds + LDS_STG};
        pg8::gemm_phase<pg8::Epi<0>, pg8::StaticOrder, true, true>(lds, g, S, E);
    }
    }
    xcd_barrier(xbar);

    for (int rep_ = 0; rep_ < ATTN_REPS; ++rep_) { PTRS();
    {
        const AttnPtrs PM{Q, PROJ, KN, KPE, VTM, CL, OM};
        const AttnPtrs PF{Q, PROJ, KN, KPE, VTF, CL, OF};
        for (int rm_ = 0; rm_ < MLA_REPS; ++rm_)
        for (int idx = bx; idx < 1024; idx += G) {
            const int c = idx & 255, r = idx >> 8, bh = c >> 1;
            const int qb = (c & 1) ? ((r == 0) ? 2 : (r == 1) ? 5 : (r == 2) ? 3 : 4) : ((r == 0) ? 0 : (r == 1) ? 7 : (r == 2) ? 1 : 6);
#ifndef NO_MLA
            attn_unit<true>(lds, PM, bh >> 3, bh & 7, qb);
#endif
        }
        for (int rf_ = 0; rf_ < FOX_REPS; ++rf_)
        for (int idx = bx; idx < 1024; idx += G) {
            const int c = idx & 255, r = idx >> 8, bh = c >> 1;
            const int qb = (c & 1) ? ((r == 0) ? 2 : (r == 1) ? 5 : (r == 2) ? 3 : 4) : ((r == 0) ? 0 : (r == 1) ? 7 : (r == 2) ? 1 : 6);
#ifndef NO_FOX
            attn_unit<false>(lds, PF, bh >> 3, bh & 7, qb);
#endif
        }
    }
    }
    xcd_barrier(xbar);

    { PTRS();
    {
        pg8::Gemm g{OM, Wbm_t, T, DM, 1024}; pg8::StaticOrder S; S.init(T, DM, G, bx);
        pg8::Epi<3> E{MERGED, DM, nullptr, PROJ + PC_GATE, NPROJ, nullptr, nullptr, 0, lds + LDS_STG};
        pg8::gemm_phase<pg8::Epi<3>, pg8::StaticOrder, true, true>(lds, g, S, E);
    }
    {
        pg8::Gemm g{OF, Wbf_t, T, DM, 1024}; pg8::StaticOrder S; S.init(T, DM, G, bx);
        pg8::Epi<4> E{MERGED, DM, nullptr, PROJ + PC_GATE + 2048, NPROJ, nullptr, nullptr, 0, lds + LDS_STG};
        pg8::gemm_phase<pg8::Epi<4>, pg8::StaticOrder, true, true>(lds, g, S, E);
    }
    }
    xcd_barrier(xbar);

    { PTRS();
    {
        pg8::Gemm g{MERGED, Wout_t, T, DM, DM}; pg8::StaticOrder S; S.init(T, DM, G, bx);
        pg8::Epi<0> E{Y, DM, nullptr, nullptr, 0, nullptr, nullptr, 0, lds + LDS_STG};
        pg8::gemm_phase<pg8::Epi<0>, pg8::StaticOrder, true, true>(lds, g, S, E);
    }
    }
    xcd_barrier(xbar);

    { PTRS();
    const f32x4* g1 = (const f32x4*)a.in[I_POST_MIX] + lane; const f32x4* g2 = (const f32x4*)a.in[I_PRE_FFN] + lane;
    for (int m0 = gw * 2; m0 < T; m0 += NGW * 2) {
        u32x2 yw[2][8]; f32x4 xv[2][8];
#pragma unroll
        for (int u = 0; u < 2; ++u) { const u32x2* yr = (const u32x2*)(Y + (size_t)(m0 + u) * DM) + lane; const f32x4* xr = (const f32x4*)(x + (size_t)(m0 + u) * DM) + lane;
#pragma unroll
            for (int j = 0; j < 8; ++j) { yw[u][j] = yr[64 * j]; xv[u][j] = xr[64 * j]; } }
#pragma unroll
        for (int u = 0; u < 2; ++u) { const int m = m0 + u;
            f32x4 v[8]; float s = 0.f;
#pragma unroll
            for (int j = 0; j < 8; ++j) { const u32x2 w_ = yw[u][j]; v[j] = (f32x4){bflo(w_.x), bfhi(w_.x), bflo(w_.y), bfhi(w_.y)}; s += (v[j].x * v[j].x + v[j].y * v[j].y) + (v[j].z * v[j].z + v[j].w * v[j].w); }
            const float r = rsqrtf(wave_sum(s) * (1.f / DM) + EPS);
            float s2 = 0.f;
#pragma unroll
            for (int j = 0; j < 8; ++j) { v[j] = xv[u][j] + v[j] * r * g1[64 * j]; s2 += (v[j].x * v[j].x + v[j].y * v[j].y) + (v[j].z * v[j].z + v[j].w * v[j].w); }
            const float r2 = rsqrtf(wave_sum(s2) * (1.f / DM) + EPS);
            u32x2* xo = (u32x2*)(X1 + (size_t)m * DM) + lane; u32x2* ho = (u32x2*)(H + (size_t)m * DM) + lane;
#pragma unroll
            for (int j = 0; j < 8; ++j) { u32x2 xw; xw.x = pk2(v[j].x, v[j].y); xw.y = pk2(v[j].z, v[j].w); xo[64 * j] = xw; const f32x4 gg = g2[64 * j]; u32x2 w; w.x = pk2(v[j].x * r2 * gg.x, v[j].y * r2 * gg.y); w.y = pk2(v[j].z * r2 * gg.z, v[j].w * r2 * gg.w); ho[64 * j] = w; }
        }
    }
    }
    xcd_barrier(xbar);

    for (int rep_ = 0; rep_ < UP_REPS; ++rep_) { PTRS();
        pg8::Gemm g{H, Wup_t, T, DFF2, DM}; pg8::StaticOrder S; S.init(T, DFF2, G, bx);
        pg8::EpiConv E{ACT, HU, a.in[I_CONVW], a.in[I_CONVB], lds + 131072, DFF2 / 256, DFF};
        pg8::gemm_phase<pg8::EpiConv, pg8::StaticOrder, true, true>(lds, g, S, E);
    }
    xcd_barrier(xbar);
    { PTRS();
        const float* cw = a.in[I_CONVW]; const float* cb = a.in[I_CONVB];
        constexpr int NN = DFF2 / 256;
        for (int i = bx * 512 + tid; i < (T / 256) * NN * 32; i += G * 512) {
            const int c4 = (i & 31) * 4, pn = (i >> 5) % NN, pm = (i >> 5) / NN, ch0 = pn * 128 + c4;
            const bool first = (pm & 7) == 0;
            f32x4 tg[2], tv[2], pg[2], pv[2];
#pragma unroll
            for (int sl = 0; sl < 2; ++sl) {
                tg[sl] = *(const f32x4*)(HU + ((size_t)(pm * 4 + sl) * NN + pn) * 256 + c4); tv[sl] = *(const f32x4*)(HU + ((size_t)(pm * 4 + sl) * NN + pn) * 256 + 128 + c4);
                if (!first) { pg[sl] = *(const f32x4*)(HU + ((size_t)((pm - 1) * 4 + 2 + sl) * NN + pn) * 256 + c4); pv[sl] = *(const f32x4*)(HU + ((size_t)((pm - 1) * 4 + 2 + sl) * NN + pn) * 256 + 128 + c4); }
                else { pg[sl] = (f32x4){0.f, 0.f, 0.f, 0.f}; pv[sl] = pg[sl]; }
            }
            const f32x4 wg0 = *(const f32x4*)(cw + ch0), wg1 = *(const f32x4*)(cw + DFF2 + ch0), wg2 = *(const f32x4*)(cw + 2 * DFF2 + ch0);
            const f32x4 wv0 = *(const f32x4*)(cw + DFF + ch0), wv1 = *(const f32x4*)(cw + DFF2 + DFF + ch0), wv2 = *(const f32x4*)(cw + 2 * DFF2 + DFF + ch0);
            const f32x4 bg = *(const f32x4*)(cb + ch0), bv = *(const f32x4*)(cb + DFF + ch0);
            const f32x4 g_r0 = wg2 * tg[0] + wg1 * pg[1] + wg0 * pg[0] + bg, v_r0 = wv2 * tv[0] + wv1 * pv[1] + wv0 * pv[0] + bv;
            const f32x4 g_r1 = wg2 * tg[1] + wg1 * tg[0] + wg0 * pg[1] + bg, v_r1 = wv2 * tv[1] + wv1 * tv[0] + wv0 * pv[1] + bv;
            u32x2 w0, w1;
            w0.x = pk2(gelu_tanh(g_r0[0]) * v_r0[0], gelu_tanh(g_r0[1]) * v_r0[1]); w0.y = pk2(gelu_tanh(g_r0[2]) * v_r0[2], gelu_tanh(g_r0[3]) * v_r0[3]);
            w1.x = pk2(gelu_tanh(g_r1[0]) * v_r1[0], gelu_tanh(g_r1[1]) * v_r1[1]); w1.y = pk2(gelu_tanh(g_r1[2]) * v_r1[2], gelu_tanh(g_r1[3]) * v_r1[3]);
            *(u32x2*)(ACT + (size_t)(pm * 256) * DFF + ch0) = w0; *(u32x2*)(ACT + (size_t)(pm * 256 + 1) * DFF + ch0) = w1;
        }
    }
    xcd_barrier(xbar);
    { PTRS();
        pg8::Gemm g{ACT, Wdn_t, T, DM, DFF}; pg8::StaticOrder S; S.init(T, DM, G, bx);
        pg8::Epi<0> E{FF, DM, nullptr, nullptr, 0, nullptr, nullptr, 0, lds + LDS_STG};
        pg8::gemm_phase<pg8::Epi<0>, pg8::StaticOrder, true, true>(lds, g, S, E);
    }
    xcd_barrier(xbar);
    { PTRS();
        const f32x4* g1 = (const f32x4*)a.in[I_POST_FFN] + lane;
        for (int m0 = gw * 2; m0 < T; m0 += NGW * 2) {
            u32x2 fw[2][8]; u32x2 xv[2][8];
#pragma unroll
            for (int u = 0; u < 2; ++u) { const u32x2* fr_ = (const u32x2*)(FF + (size_t)(m0 + u) * DM) + lane; const u32x2* xr = (const u32x2*)(X1 + (size_t)(m0 + u) * DM) + lane;
#pragma unroll
                for (int j = 0; j < 8; ++j) { fw[u][j] = fr_[64 * j]; xv[u][j] = xr[64 * j]; } }
#pragma unroll
            for (int u = 0; u < 2; ++u) {
                f32x4 v[8]; float s = 0.f;
#pragma unroll
                for (int j = 0; j < 8; ++j) { const u32x2 w_ = fw[u][j]; v[j] = (f32x4){bflo(w_.x), bfhi(w_.x), bflo(w_.y), bfhi(w_.y)}; s += (v[j].x * v[j].x + v[j].y * v[j].y) + (v[j].z * v[j].z + v[j].w * v[j].w); }
                const float r = rsqrtf(wave_sum(s) * (1.f / DM) + EPS);
                f32x4* xo = (f32x4*)(OUT + (size_t)(m0 + u) * DM) + lane;
#pragma unroll
                for (int j = 0; j < 8; ++j) { const u32x2 xw = xv[u][j]; xo[64 * j] = (f32x4){bflo(xw.x), bfhi(xw.x), bflo(xw.y), bfhi(xw.y)} + v[j] * r * g1[64 * j]; }
            }
        }
    }
}

extern "C" void kernel_launch(void* const* d_in, const int* in_sizes, int n_in, void* d_out, int out_size, void* d_ws, size_t ws_size, hipStream_t stream) {
    static int grid = 0;
    if (grid == 0) {
        if (n_in != 20 || ws_size < WS_END) { fprintf(stderr, "kernel_launch: unexpected n_in %d / ws_size %zu\n", n_in, ws_size); grid = -1; return; }
        int dev = 0, cus = 0, per_cu = 0;
        hipGetDevice(&dev); hipDeviceGetAttribute(&cus, hipDeviceAttributeMultiprocessorCount, dev);
        hipFuncSetAttribute((const void*)mega_fwd, hipFuncAttributeMaxDynamicSharedMemorySize, LDS_BYTES);
        hipOccupancyMaxActiveBlocksPerMultiprocessor(&per_cu, (const void*)mega_fwd, 512, LDS_BYTES);
        if (per_cu < 1) { fprintf(stderr, "kernel_launch: occupancy query says %d blocks per CU\n", per_cu); per_cu = 1; }
        (void)hipGetLastError();
        grid = cus * per_cu;
        if (grid > 256) grid = 256;
    }
    if (grid < 0) return;
    Args a{};
    for (int i = 0; i < 20; ++i) a.in[i] = (const float*)d_in[i];
    a.out = (float*)d_out; a.ws = (unsigned char*)d_ws;
    for (int i = 0; i < 32; ++i) { const float p = (float)pow(10000.0, (double)(2 * i) / 64.0); a.inv_freq[i] = 1.0f / p; }
    void* args[] = {&a};
    (void)hipMemsetAsync((unsigned char*)d_ws + WS_BAR, 0, XCD_BAR_WORDS * 4, stream);
    hipError_t e = hipLaunchCooperativeKernel((const void*)mega_fwd, dim3(grid), dim3(512), args, LDS_BYTES, stream);
    if (e != hipSuccess) fprintf(stderr, "cooperative launch failed: %s (grid %d)\n", hipGetErrorString(e), grid);
}
```

```cpp
#include <hip/hip_runtime.h>
#include <hip/hip_cooperative_groups.h>
#include <cstdio>
#include <cstdint>
#include <cmath>
namespace cg = cooperative_groups;

namespace pg8 {
#define PG8_LAS __attribute__((address_space(3)))
typedef unsigned short bf16_t;
typedef short bf16x8 __attribute__((ext_vector_type(8)));
typedef float f32x4 __attribute__((ext_vector_type(4)));
typedef unsigned u32x4 __attribute__((ext_vector_type(4)));
constexpr int BM = 256, BK = 64, HALF = 128, HTB = HALF * BK * 2  , STAGE_BYTES = 8 * HTB, NXCD = 8, WGM = 8;

__host__ __device__ __forceinline__ int lds_byte(int r, int c) { const int st = (r >> 4) * 2 + (c >> 5), rr = r & 15, cc = c & 31, ob = rr * 64 + cc * 2; return st * 1024 + (ob ^ (((ob >> 9) & 1) << 5)); }
__host__ __device__ __forceinline__ void stage_rc(int b, int& R, int& C) { const int st = b / 1024, sb = b % 1024, swz = sb ^ (((sb >> 9) & 1) << 5); R = (st >> 1) * 16 + swz / 64; C = (st & 1) * 32 + (swz % 64) / 2; }
__host__ __device__ __forceinline__ int perm32(int rho) { const int n = rho >> 4, i = rho & 15; return 8 * (i >> 2) + 4 * n + (i & 3); }

struct Unit { int pm, pn; };
struct Gemm { const bf16_t* A; const bf16_t* Bt; int M, N, K; };

struct StaticOrder {
    int nM, nN, nwg, G, c;
    __host__ __device__ void init(int M, int N, int G_, int c_) { nM = M / BM; nN = N / BM; nwg = nM * nN; G = G_; c = c_; }
    __host__ __device__ bool next(int i, Unit& u) const {
        const long L = (long)i * G + c; if (L >= nwg) return false;
        int wgid = (int)L; { const int q = nwg / NXCD, r = nwg % NXCD, xcd = wgid % NXCD, off = wgid / NXCD; wgid = (xcd < r ? xcd * (q + 1) : r * (q + 1) + (xcd - r) * q) + off; }
        const int nig = WGM * nN, gid = wgid / nig, fm = gid * WGM, gsz = (nM - fm) < WGM ? (nM - fm) : WGM;
        u.pm = fm + ((wgid % nig) % gsz); u.pn = (wgid % nig) / gsz; return true;
    }
    __device__ __forceinline__ void a_ready(const Unit&) const {}
    __device__ __forceinline__ void done(const Unit&) const {}
};

__device__ __forceinline__ unsigned cvt_pk_bf16(float lo, float hi) { unsigned r; asm volatile("v_cvt_pk_bf16_f32 %0, %1, %2" : "=v"(r) : "v"(lo), "v"(hi)); return r; }
typedef unsigned u32x4 __attribute__((ext_vector_type(4)));
__device__ __forceinline__ float bf_lo(unsigned w) { return __uint_as_float(w << 16); }
__device__ __forceinline__ float bf_hi(unsigned w) { return __uint_as_float(w & 0xffff0000u); }
__device__ __forceinline__ float fsigmoid(float x) { return __builtin_amdgcn_rcpf(1.0f + __expf(-x)); }
#define GAS1 __attribute__((address_space(1)))
template <int MODE> struct Epi {
    static constexpr bool PERM = true, AFTER_DRAIN = false;
    void* O; int ldc; const float* bias; const bf16_t* G; int ldg; const float* cosT; const float* sinT; int ntile_special; PG8_LAS unsigned char* stg;
    __device__ __forceinline__ void operator()(const f32x4 (&acc)[2][2][4][2], const Unit& u, int wr, int wc, int fr, int fq) const {
        const int row0 = u.pm * BM + wr * 64 + fr, col0 = u.pn * BM + wc * 64 + 8 * fq;
        PG8_LAS unsigned char* sl = stg + (wr * 4 + wc) * 2304; const int L = fq * 16 + fr;
        const unsigned wa = (unsigned)(size_t)(sl + fr * 144 + fq * 16), ra = (unsigned)(size_t)(sl + (L >> 3) * 144 + (L & 7) * 16);
        const bool special = (MODE == 1) ? (u.pn < ntile_special) : (MODE == 2 ? (u.pn >= ntile_special) : false);
        u32x4 rb[2][2];
        bf16_t* obase = (bf16_t*)O + (size_t)(u.pm * BM + wr * 64 + (L >> 3)) * ldc + u.pn * BM + wc * 64 + 8 * (L & 7);
#pragma unroll
        for (int g = 0; g < 8; ++g) {
            const int ai = g >> 2, m = g & 3;
            const int row = row0 + ai * HALF + m * 16;
#pragma unroll
            for (int bj = 0; bj < 2; ++bj) {
                const int col = col0 + bj * 32;
                f32x4 v0 = acc[ai][bj][m][0], v1 = acc[ai][bj][m][1];
                if (MODE == 1) {
                    if (special) {
                        const f32x4 b0 = *(const GAS1 f32x4*)(bias + col) * -1.4426950408889634f, b1 = *(const GAS1 f32x4*)(bias + col + 4) * -1.4426950408889634f;
#pragma unroll
                        for (int j = 0; j < 4; ++j) { v0[j] = __builtin_amdgcn_rcpf(1.0f + __builtin_amdgcn_exp2f(__builtin_fmaf(v0[j], -1.4426950408889634f, b0[j])));
                                                      v1[j] = __builtin_amdgcn_rcpf(1.0f + __builtin_amdgcn_exp2f(__builtin_fmaf(v1[j], -1.4426950408889634f, b1[j]))); }
                    }
                }
                if (MODE == 2) {
                    if (special) {
                        const int fi = ((col & 63) >> 3) * 4;
                        const f32x4 c = *(const GAS1 f32x4*)(cosT + (size_t)row * 32 + fi), s_ = *(const GAS1 f32x4*)(sinT + (size_t)row * 32 + fi);
                        const f32x4 o1 = v0 * c - v1 * s_, o2 = v1 * c + v0 * s_; v0 = o1; v1 = o2;
                    }
                }
                if (MODE == 3 || MODE == 4) {
                    const u32x4 gw = *(const GAS1 u32x4*)(G + (size_t)row * ldg + col);
                    const f32x4 g0 = {bf_lo(gw.x), bf_hi(gw.x), bf_lo(gw.y), bf_hi(gw.y)}, g1 = {bf_lo(gw.z), bf_hi(gw.z), bf_lo(gw.w), bf_hi(gw.w)};
                    v0 = v0 * g0; v1 = v1 * g1;
                    if (MODE == 4) {
                        const u32x4 ow = *(const GAS1 u32x4*)((const bf16_t*)O + (size_t)row * ldc + col);
                        const f32x4 o0 = {bf_lo(ow.x), bf_hi(ow.x), bf_lo(ow.y), bf_hi(ow.y)}, o1 = {bf_lo(ow.z), bf_hi(ow.z), bf_lo(ow.w), bf_hi(ow.w)};
                        v0 += o0; v1 += o1;
                    }
                }
                u32x4 w; w.x = cvt_pk_bf16(v0[0], v0[1]); w.y = cvt_pk_bf16(v0[2], v0[3]); w.z = cvt_pk_bf16(v1[0], v1[1]); w.w = cvt_pk_bf16(v1[2], v1[3]);
                if (bj == 0) asm volatile("ds_write_b128 %0, %1" :: "v"(wa), "v"(w)); else asm volatile("ds_write_b128 %0, %1 offset:64" :: "v"(wa), "v"(w));
            }
            asm volatile("ds_read_b128 %0, %1" : "=&v"(rb[g & 1][0]) : "v"(ra));
            asm volatile("ds_read_b128 %0, %1 offset:1152" : "=&v"(rb[g & 1][1]) : "v"(ra));
            if (g >= 1) {
                asm volatile("s_waitcnt lgkmcnt(4)" : "+v"(rb[(g - 1) & 1][0]), "+v"(rb[(g - 1) & 1][1]));
                bf16_t* ob = obase + (size_t)(((g - 1) >> 2) * HALF + ((g - 1) & 3) * 16) * ldc;
                *(GAS1 u32x4*)ob = rb[(g - 1) & 1][0]; *(GAS1 u32x4*)(ob + (size_t)8 * ldc) = rb[(g - 1) & 1][1];
            }
        }
        asm volatile("s_waitcnt lgkmcnt(0)" : "+v"(rb[1][0]), "+v"(rb[1][1]));
        { bf16_t* ob = obase + (size_t)(HALF + 3 * 16) * ldc; *(GAS1 u32x4*)ob = rb[1][0]; *(GAS1 u32x4*)(ob + (size_t)8 * ldc) = rb[1][1]; }
    }
};


__device__ __forceinline__ float dpp_prev1(float prev, float cur) {
    const int t = __builtin_amdgcn_update_dpp(0, __builtin_bit_cast(int, prev), 0x121, 0xf, 0xf, false);
    return __builtin_bit_cast(float, __builtin_amdgcn_update_dpp(t, __builtin_bit_cast(int, cur), 0x111, 0xf, 0xf, false));
}
__device__ __forceinline__ float dpp_prev2(float prev, float cur) {
    const int t = __builtin_amdgcn_update_dpp(0, __builtin_bit_cast(int, prev), 0x122, 0xf, 0xf, false);
    return __builtin_bit_cast(float, __builtin_amdgcn_update_dpp(t, __builtin_bit_cast(int, cur), 0x112, 0xf, 0xf, false));
}
__device__ __forceinline__ float gelu_tanh_f(float x) {
    const float q = __builtin_fmaf(x * x, -0.10294325f, -2.3022082f);
    return x * __builtin_amdgcn_rcpf(1.0f + __builtin_amdgcn_exp2f(x * q));
}
typedef _Float16 h2_t __attribute__((ext_vector_type(2)));
__device__ __forceinline__ h2_t pkh(float a, float b) { return __builtin_bit_cast(h2_t, __builtin_amdgcn_cvt_pkrtz(a, b)); }
__device__ __forceinline__ h2_t pkh_rn(float a, float b) { h2_t r; r.x = (_Float16)a; r.y = (_Float16)b; return r; }
__device__ __forceinline__ h2_t dpph1(h2_t prev, h2_t cur) {
    const int pi = __builtin_bit_cast(int, prev), t = __builtin_amdgcn_update_dpp(pi, pi, 0x121, 0xf, 0xf, false);
    return __builtin_bit_cast(h2_t, __builtin_amdgcn_update_dpp(t, __builtin_bit_cast(int, cur), 0x111, 0xf, 0xf, false));
}
__device__ __forceinline__ h2_t dpph2(h2_t prev, h2_t cur) {
    const int pi = __builtin_bit_cast(int, prev), t = __builtin_amdgcn_update_dpp(pi, pi, 0x122, 0xf, 0xf, false);
    return __builtin_bit_cast(h2_t, __builtin_amdgcn_update_dpp(t, __builtin_bit_cast(int, cur), 0x112, 0xf, 0xf, false));
}
typedef unsigned u32x2e __attribute__((ext_vector_type(2)));
struct EpiConv {
    static constexpr bool PERM = true, AFTER_DRAIN = false;
    bf16_t* ACT; float* HU; const float* cw; const float* cb; PG8_LAS unsigned char* hl; int nN; int dff;
    __device__ __forceinline__ int hidx(int ai, int wr, int wc, int slot, int bj, int fq, int n) const { return ((((((ai * 2 + wr) * 4 + wc) * 2 + slot) * 2 + bj) * 4 + fq) * 2 + n) * 16; }
    __device__ __forceinline__ void operator()(const f32x4 (&acc)[2][2][4][2], const Unit& u, int wr, int wc, int fr, int fq) const {
        if (fr >= 14) {
#pragma unroll
            for (int ai = 0; ai < 2; ++ai)
#pragma unroll
                for (int bj = 0; bj < 2; ++bj)
#pragma unroll
                    for (int n = 0; n < 2; ++n) *(PG8_LAS f32x4*)(hl + hidx(ai, wr, wc, fr - 14, bj, fq, n)) = acc[ai][bj][3][n];
            if (wr == 1) {
#pragma unroll
                for (int bj = 0; bj < 2; ++bj)
#pragma unroll
                    for (int n = 0; n < 2; ++n) *(f32x4*)(HU + ((size_t)(u.pm * 4 + 2 + (fr - 14)) * nN + u.pn) * 256 + 128 * bj + 32 * wc + 8 * fq + 4 * n) = acc[1][bj][3][n];
            }
        }
        if (fr < 2 && wr == 0) {
#pragma unroll
            for (int bj = 0; bj < 2; ++bj)
#pragma unroll
                for (int n = 0; n < 2; ++n) *(f32x4*)(HU + ((size_t)(u.pm * 4 + fr) * nN + u.pn) * 256 + 128 * bj + 32 * wc + 8 * fq + 4 * n) = acc[0][bj][0][n];
        }
        asm volatile("s_waitcnt lgkmcnt(0)" ::: "memory"); __builtin_amdgcn_s_barrier(); asm volatile("" ::: "memory");
        const int row0 = u.pm * BM + wr * 64 + fr;
        u32x2e res[2][4];
#pragma unroll
        for (int n = 0; n < 2; ++n) {
            const int ch0 = u.pn * 128 + wc * 32 + 8 * fq + 4 * n;
            const f32x4 wg0 = *(const f32x4*)(cw + ch0), wg1 = *(const f32x4*)(cw + 2 * dff + ch0), wg2 = *(const f32x4*)(cw + 4 * dff + ch0);
            const f32x4 wv0 = *(const f32x4*)(cw + dff + ch0), wv1 = *(const f32x4*)(cw + 3 * dff + ch0), wv2 = *(const f32x4*)(cw + 5 * dff + ch0);
            const f32x4 bg = *(const f32x4*)(cb + ch0), bv = *(const f32x4*)(cb + dff + ch0);
            h2_t wg0h[2], wg1h[2], wg2h[2], wv0h[2], wv1h[2], wv2h[2], bgh[2], bvh[2];
#pragma unroll
            for (int p = 0; p < 2; ++p) { wg0h[p] = pkh_rn(wg0[2 * p], wg0[2 * p + 1]); wg1h[p] = pkh_rn(wg1[2 * p], wg1[2 * p + 1]); wg2h[p] = pkh_rn(wg2[2 * p], wg2[2 * p + 1]);
                wv0h[p] = pkh_rn(wv0[2 * p], wv0[2 * p + 1]); wv1h[p] = pkh_rn(wv1[2 * p], wv1[2 * p + 1]); wv2h[p] = pkh_rn(wv2[2 * p], wv2[2 * p + 1]);
                bgh[p] = pkh_rn(bg[2 * p], bg[2 * p + 1]); bvh[p] = pkh_rn(bv[2 * p], bv[2 * p + 1]); }
#pragma unroll
            for (int ai = 0; ai < 2; ++ai) {
                f32x4 pg = {0.f, 0.f, 0.f, 0.f}, pv = pg;
                const bool has = !(ai == 0 && wr == 0);
                if (has && fr >= 14) { const int pai = (wr == 1) ? ai : ai - 1, pwr = (wr == 1) ? 0 : 1;
                    pg = *(const PG8_LAS f32x4*)(hl + hidx(pai, pwr, wc, fr - 14, 0, fq, n)); pv = *(const PG8_LAS f32x4*)(hl + hidx(pai, pwr, wc, fr - 14, 1, fq, n)); }
                h2_t qgh[2] = {pkh(pg[0], pg[1]), pkh(pg[2], pg[3])}, qvh[2] = {pkh(pv[0], pv[1]), pkh(pv[2], pv[3])};
#pragma unroll
                for (int m = 0; m < 4; ++m) {
                    const f32x4 cg = acc[ai][0][m][n], cv = acc[ai][1][m][n];
                    const h2_t cgh[2] = {pkh(cg[0], cg[1]), pkh(cg[2], cg[3])}, cvh[2] = {pkh(cv[0], cv[1]), pkh(cv[2], cv[3])};
                    float o[4];
#pragma unroll
                    for (int p = 0; p < 2; ++p) {
                        const h2_t g1 = dpph1(qgh[p], cgh[p]), g2 = dpph2(qgh[p], cgh[p]);
                        const h2_t v1 = dpph1(qvh[p], cvh[p]), v2 = dpph2(qvh[p], cvh[p]);
                        const h2_t gg = wg2h[p] * cgh[p] + wg1h[p] * g1 + wg0h[p] * g2 + bgh[p];
                        const h2_t vv = wv2h[p] * cvh[p] + wv1h[p] * v1 + wv0h[p] * v2 + bvh[p];
                        const h2_t q = gg * gg * (h2_t){(_Float16)-0.10294325f, (_Float16)-0.10294325f} + (h2_t){(_Float16)-2.3022082f, (_Float16)-2.3022082f};
                        const h2_t arg = gg * q;
                        h2_t ex; ex.x = __builtin_exp2f16(arg.x); ex.y = __builtin_exp2f16(arg.y);
                        const h2_t den = ex + (h2_t){(_Float16)1.0f, (_Float16)1.0f};
                        h2_t rc; rc.x = __builtin_amdgcn_rcph(den.x); rc.y = __builtin_amdgcn_rcph(den.y);
                        const h2_t og = gg * rc * vv;
                        o[2 * p] = (float)og.x; o[2 * p + 1] = (float)og.y;
                        qgh[p] = cgh[p]; qvh[p] = cvh[p];
                    }
                    u32x2e w; w.x = cvt_pk_bf16(o[0], o[1]); w.y = cvt_pk_bf16(o[2], o[3]);
                    if (n == 0) res[ai][m] = w;
                    else { u32x4 w4; w4.x = res[ai][m].x; w4.y = res[ai][m].y; w4.z = w.x; w4.w = w.y;
                           *(u32x4*)(ACT + (size_t)(row0 + ai * HALF + m * 16) * dff + ch0 - 4) = w4; }
                }
            }
        }
    }
};

template <class Epi, class Sched, bool ALIGN_EPI = false, bool SP2 = false>
__device__ __forceinline__ void gemm_phase(PG8_LAS unsigned char* lds, const Gemm g, const Sched& S, const Epi& E) {
    int tid_ = threadIdx.x; asm volatile("" : "+v"(tid_));
    const int tid = tid_, wid = __builtin_amdgcn_readfirstlane(tid >> 6), lane = tid & 63, wr = wid >> 2, wc = wid & 3, fr = lane & 15, fq = lane >> 4;
    const int K = g.K, nt = K / BK;
    unsigned voffA[2], voffB[2];
#pragma unroll
    for (int i = 0; i < 2; ++i) { int R, C; stage_rc(tid * 16 + i * 8192, R, C); const int Rb = Epi::PERM ? (64 * (R >> 5) + perm32(R & 31)) : R;
        voffA[i] = (unsigned)(R * K + C) * 2u; voffB[i] = (unsigned)(Rb * K + C) * 2u; }
    const size_t kstep = (size_t)(BK * 2);
    const size_t hstep = (size_t)HALF * K * 2;
    const size_t hstepB = Epi::PERM ? (size_t)32 * K * 2 : hstep;
    const size_t tstep = 2 * hstep;
    const unsigned ldsw = (unsigned)wid * 1024u;
    const int aoff = lds_byte(wr * 64 + fr, fq * 8), boff = lds_byte(wc * 32 + fr, fq * 8);
#define PG8_SA(b, h) (((b) * 2 + (h)) * HTB)
#define PG8_SB(b, h) ((4 + (b) * 2 + (h)) * HTB)
#define PG8_STAGE(bufoff, gbase, voff) do { _Pragma("unroll") for (int _i = 0; _i < 2; ++_i) \
        __builtin_amdgcn_global_load_lds((const unsigned*)((const char*)(gbase) + (voff)[_i]), (PG8_LAS unsigned*)(lds + (bufoff) + ldsw + _i * 8192), 16, 0, 0); } while (0)
#define PG8_LDA(dst, b, h) do { _Pragma("unroll") for (int m = 0; m < 4; ++m) _Pragma("unroll") for (int k = 0; k < 2; ++k) dst[m][k] = *(const PG8_LAS bf16x8*)(lds + PG8_SA(b, h) + aoff + m * 2048 + k * 1024); } while (0)
#define PG8_LDB(dst, b, h) do { _Pragma("unroll") for (int n = 0; n < 2; ++n) _Pragma("unroll") for (int k = 0; k < 2; ++k) dst[n][k] = *(const PG8_LAS bf16x8*)(lds + PG8_SB(b, h) + boff + n * 2048 + k * 1024); } while (0)
#define PG8_MMA(ai, bj, At, Bt) do { __builtin_amdgcn_s_setprio(1); _Pragma("unroll") for (int m = 0; m < 4; ++m) _Pragma("unroll") for (int n = 0; n < 2; ++n) _Pragma("unroll") for (int k = 0; k < 2; ++k) \
        acc[ai][bj][m][n] = __builtin_amdgcn_mfma_f32_16x16x32_bf16(Bt[n][k], At[m][k], acc[ai][bj][m][n], 0, 0, 0); __builtin_amdgcn_s_setprio(0); } while (0)
#define PG8_WAIT_V(n) asm volatile("s_waitcnt vmcnt(" #n ")" ::: "memory")
#define PG8_WAIT_L(n) asm volatile("s_waitcnt lgkmcnt(" #n ")" ::: "memory")
#define PG8_BAR __builtin_amdgcn_s_barrier()
#define PG8_SCHED __builtin_amdgcn_sched_barrier(0)
    Unit cur, nxt; int ui = 0;
    if (!S.next(0, cur)) return;
    f32x4 acc[2][2][4][2];
#pragma unroll
    for (int a = 0; a < 2; ++a)
#pragma unroll
        for (int b = 0; b < 2; ++b)
#pragma unroll
            for (int m = 0; m < 4; ++m)
#pragma unroll
                for (int n = 0; n < 2; ++n) acc[a][b][m][n] = (f32x4){0.f, 0.f, 0.f, 0.f};
    bf16x8 At[4][2], B0[2][2], B1[2][2];
    const char* cA = (const char*)g.A + (size_t)cur.pm * tstep; const char* cB = (const char*)g.Bt + (size_t)cur.pn * tstep;
    S.a_ready(cur);
    if constexpr (SP2) {
        PG8_STAGE(PG8_SB(0, 0), cB, voffB); PG8_STAGE(PG8_SB(0, 1), cB + hstepB, voffB); PG8_STAGE(PG8_SA(0, 0), cA, voffA); PG8_STAGE(PG8_SA(0, 1), cA + hstep, voffA);
        if (wr == 1) PG8_BAR;
        PG8_WAIT_V(2); PG8_BAR;
        PG8_STAGE(PG8_SB(1, 0), cB + kstep, voffB); PG8_STAGE(PG8_SA(1, 0), cA + kstep, voffA); PG8_STAGE(PG8_SB(1, 1), cB + hstepB + kstep, voffB);
        PG8_WAIT_V(6); PG8_BAR;
    } else {
        PG8_STAGE(PG8_SB(0, 0), cB, voffB); PG8_STAGE(PG8_SA(0, 0), cA, voffA); PG8_STAGE(PG8_SB(0, 1), cB + hstepB, voffB); PG8_STAGE(PG8_SA(0, 1), cA + hstep, voffA);
        if (wr == 1) PG8_BAR;
        PG8_WAIT_V(4); PG8_BAR;
        PG8_STAGE(PG8_SB(1, 0), cB + kstep, voffB); PG8_STAGE(PG8_SA(1, 0), cA + kstep, voffA); PG8_STAGE(PG8_SB(1, 1), cB + hstepB + kstep, voffB);
        PG8_WAIT_V(6); PG8_BAR;
    }
    for (;;) {
        const bool has_next = S.next(ui + 1, nxt);
        const char* nA = has_next ? (const char*)g.A + (size_t)nxt.pm * tstep : cA; const char* nB = has_next ? (const char*)g.Bt + (size_t)nxt.pn * tstep : cB;
        for (int t = 0; t < nt; t += 2) {
            const bool last = (t == nt - 2);
            const char* a1 = cA + (size_t)(t + 1) * kstep;
            const char* a2 = last ? nA : cA + (size_t)(t + 2) * kstep; const char* b2 = last ? nB : cB + (size_t)(t + 2) * kstep;
            const char* a3 = a2 + kstep; const char* b3 = b2 + kstep;
            if (last && has_next) S.a_ready(nxt);
            if constexpr (SP2) {
            PG8_LDB(B0, 0, 0); PG8_LDB(B1, 0, 1); PG8_SCHED; PG8_LDA(At, 0, 0); PG8_STAGE(PG8_SA(1, 1), a1 + hstep, voffA);
            PG8_WAIT_V(8); PG8_WAIT_L(0); PG8_BAR; PG8_MMA(0, 0, At, B0); PG8_MMA(0, 1, At, B1); PG8_BAR; PG8_SCHED;
            PG8_LDA(At, 0, 1); PG8_STAGE(PG8_SB(0, 0), b2, voffB); PG8_STAGE(PG8_SB(0, 1), b2 + hstepB, voffB); PG8_STAGE(PG8_SA(0, 0), a2, voffA);
            PG8_WAIT_V(8); PG8_WAIT_L(0); PG8_BAR; PG8_MMA(1, 0, At, B0); PG8_MMA(1, 1, At, B1); PG8_BAR; PG8_SCHED;
            PG8_LDB(B0, 1, 0); PG8_LDB(B1, 1, 1); PG8_SCHED; PG8_LDA(At, 1, 0); PG8_STAGE(PG8_SA(0, 1), a2 + hstep, voffA);
            PG8_WAIT_V(8); PG8_WAIT_L(0); PG8_BAR; PG8_MMA(0, 0, At, B0); PG8_MMA(0, 1, At, B1); PG8_BAR; PG8_SCHED;
            PG8_LDA(At, 1, 1); PG8_STAGE(PG8_SB(1, 0), b3, voffB); PG8_STAGE(PG8_SB(1, 1), b3 + hstepB, voffB); PG8_STAGE(PG8_SA(1, 0), a3, voffA);
            PG8_WAIT_V(8); PG8_WAIT_L(0); PG8_BAR; PG8_MMA(1, 0, At, B0); PG8_MMA(1, 1, At, B1); PG8_BAR; PG8_SCHED;
            } else {
            PG8_LDB(B0, 0, 0); PG8_SCHED; PG8_LDA(At, 0, 0); PG8_STAGE(PG8_SA(1, 1), a1 + hstep, voffA);
            PG8_WAIT_L(8); PG8_BAR; PG8_WAIT_L(0); PG8_MMA(0, 0, At, B0); PG8_BAR; PG8_SCHED;
            PG8_LDB(B1, 0, 1); PG8_STAGE(PG8_SB(0, 0), b2, voffB);
            PG8_BAR; PG8_WAIT_L(0); PG8_MMA(0, 1, At, B1); PG8_BAR;
            PG8_LDA(At, 0, 1); PG8_STAGE(PG8_SA(0, 0), a2, voffA);
            PG8_BAR; PG8_WAIT_L(0); PG8_MMA(1, 0, At, B0); PG8_BAR; PG8_SCHED;
            PG8_STAGE(PG8_SB(0, 1), b2 + hstepB, voffB);
            PG8_WAIT_V(6); PG8_BAR; PG8_MMA(1, 1, At, B1); PG8_BAR;
            PG8_LDB(B0, 1, 0); PG8_SCHED; PG8_LDA(At, 1, 0); PG8_STAGE(PG8_SA(0, 1), a2 + hstep, voffA);
            PG8_WAIT_L(8); PG8_BAR; PG8_WAIT_L(0); PG8_MMA(0, 0, At, B0); PG8_BAR; PG8_SCHED;
            PG8_LDB(B1, 1, 1); PG8_STAGE(PG8_SB(1, 0), b3, voffB);
            PG8_BAR; PG8_WAIT_L(0); PG8_MMA(0, 1, At, B1); PG8_BAR;
            PG8_LDA(At, 1, 1); PG8_STAGE(PG8_SA(1, 0), a3, voffA);
            PG8_BAR; PG8_WAIT_L(0); PG8_MMA(1, 0, At, B0); PG8_BAR; PG8_SCHED;
            PG8_STAGE(PG8_SB(1, 1), b3 + hstepB, voffB);
            PG8_WAIT_V(6); PG8_BAR; PG8_MMA(1, 1, At, B1); PG8_BAR;
            }
        }
        if constexpr (ALIGN_EPI) { if (wr == 0) PG8_BAR; }
        if constexpr (!Epi::AFTER_DRAIN) { E(acc, cur, wr, wc, fr, fq); S.done(cur); }
        if (!has_next) break;
#pragma unroll
        for (int a = 0; a < 2; ++a)
#pragma unroll
            for (int b = 0; b < 2; ++b)
#pragma unroll
                for (int m = 0; m < 4; ++m)
#pragma unroll
                    for (int n = 0; n < 2; ++n) acc[a][b][m][n] = (f32x4){0.f, 0.f, 0.f, 0.f};
        cur = nxt; cA = nA; cB = nB; ++ui;
        if constexpr (ALIGN_EPI) { if (wr == 1) PG8_BAR; }
    }
    PG8_WAIT_V(0);
    if constexpr (!ALIGN_EPI) { if (wr == 0) PG8_BAR; }
    PG8_BAR;
    if constexpr (Epi::AFTER_DRAIN) { E.fused(acc, cur, wr, wc, fr, fq, lds, wid, lane); S.done(cur); }
#undef PG8_SA
#undef PG8_SB
#undef PG8_STAGE
#undef PG8_LDA
#undef PG8_LDB
#undef PG8_MMA
#undef PG8_WAIT_V
#undef PG8_WAIT_L
#undef PG8_BAR
#undef PG8_SCHED
}
}

#include <type_traits>
#define LAS __attribute__((address_space(3)))
typedef unsigned short bf16_t;
typedef short bf16x8 __attribute__((ext_vector_type(8)));
typedef float f32x4 __attribute__((ext_vector_type(4)));
typedef float f32x16 __attribute__((ext_vector_type(16)));
typedef unsigned u32x4 __attribute__((ext_vector_type(4)));
typedef unsigned u32x2 __attribute__((ext_vector_type(2)));
constexpr int NB = 16, SEQ = 2048, T = NB * SEQ, DM = 2048, NH = 8;
constexpr int DFF = 5632, DFF2 = 2 * DFF;
constexpr int NPROJ = 7168;
constexpr int PC_GATE = 0, PC_FQ = 4096, PC_FK = 5120, PC_QLAT = 6144, PC_KVLAT = 6656, PC_KPE = 6912, PC_FLOG = 6976, PC_END = 6984;
constexpr float EPS = 1e-6f, LOG2E = 1.4426950408889634f;
constexpr int TH = T / 2;

constexpr size_t MiB = 1u << 20;
constexpr size_t WS_WIN = 0, WS_WV = 28 * MiB, WS_WUQ = 32 * MiB, WS_WKN = 34 * MiB, WS_WVM = 35 * MiB, WS_WBM = 36 * MiB, WS_WBF = 40 * MiB, WS_WOUT = 44 * MiB,
                 WS_WUP = 52 * MiB, WS_WDN = 96 * MiB;
constexpr size_t WS_H = 128 * MiB;
constexpr size_t WS_KN = 128 * MiB, WS_VTM = 192 * MiB;
constexpr size_t WS_PROJ = 256 * MiB;
constexpr size_t WS_Y = 256 * MiB;
constexpr size_t WS_ACT = 256 * MiB, WS_FF = 608 * MiB, WS_X1 = 736 * MiB, WS_HU = 864 * MiB;
constexpr size_t WS_VTF = 704 * MiB;
constexpr size_t WS_QN = 768 * MiB, WS_KVN = 800 * MiB, WS_KPE = 816 * MiB, WS_COS = 820 * MiB, WS_SIN = 824 * MiB, WS_CL = 828 * MiB;
constexpr size_t WS_Q = 832 * MiB;
constexpr size_t WS_BAR = 928 * MiB;
constexpr size_t WS_END = 929 * MiB;
constexpr int LDS_BYTES = 159744, LDS_HALO = 131072, LDS_STG = 139264, LDS_MISC = 158720;

__device__ __forceinline__ float wave_sum(float v) {
#pragma unroll
    for (int o = 1; o < 64; o <<= 1) v += __shfl_xor(v, o);
    return v;
}
__device__ __forceinline__ unsigned f2bf(float f) { unsigned u = __builtin_bit_cast(unsigned, f); return (u + 0x7fffu + ((u >> 16) & 1u)) >> 16; }
__device__ __forceinline__ unsigned pk2(float lo, float hi) { return f2bf(lo) | (f2bf(hi) << 16); }
__device__ __forceinline__ float bflo(unsigned w) { return __uint_as_float(w << 16); }
__device__ __forceinline__ float bfhi(unsigned w) { return __uint_as_float(w & 0xffff0000u); }
__device__ __forceinline__ float bf1(bf16_t h) { return __uint_as_float((unsigned)h << 16); }

__device__ __forceinline__ bf16_t* tmap(int mode, int n, bf16_t* d0, bf16_t* d1, int K, float& cs) {
    cs = 1.f;
    if (mode == 0) return d0 + (size_t)n * K;
    if (mode == 4) { const int g = (n >= DFF) ? 1 : 0, c = n - g * DFF; return d0 + (size_t)((c >> 7) * 256 + 64 * ((c & 127) >> 5) + 32 * g + (c & 31)) * K; }
    if (mode == 1) {
        int r;
        if (n < 512) r = PC_QLAT + n;
        else if (n < 768) r = PC_KVLAT + (n - 512);
        else if (n < 832) r = PC_KPE + (n - 768);
        else if (n < 1856) { r = PC_FQ + (n - 832); cs = 0.08838834764831845f * LOG2E; }
        else if (n < 2880) r = PC_FK + (n - 1856);
        else if (n < 3904) return d1 + (size_t)(n - 2880) * K;
        else if (n < 3912) r = PC_FLOG + (n - 3904);
        else r = PC_GATE + (n - 3912);
        return d0 + (size_t)r * K;
    }
    if (mode == 2) {
        cs = 0.07216878364870322f * LOG2E;
        const int hh = n / 192, d = n - hh * 192; int r;
        if (d < 128) r = hh * 128 + d;
        else { const int e = d - 128, i = e & 31, hf = e >> 5; r = 1024 + hh * 64 + 8 * (i >> 2) + 4 * hf + (i & 3); }
        return d0 + (size_t)r * K;
    }
    { const int hh = n >> 8, d = n & 255;
      if (d < 128) return d0 + (size_t)(hh * 128 + d) * K;
      return d1 + (size_t)(hh * 128 + d - 128) * K; }
}
__device__ __forceinline__ void transpose_item(const float* W, int K, int N, int mode, const float* kscale, bf16_t* d0, bf16_t* d1, LAS float* scr, int item, int lane) {
    const int nblk = (N + 31) / 32, kb = item / nblk, nb = item - kb * nblk, k0 = 64 * kb, n0 = 32 * nb;
    const int nn = n0 + (lane & 31); const bool nok = nn < N;
    float tv[32];
#pragma unroll
    for (int i = 0; i < 32; ++i) { const int kk = 2 * i + (lane >> 5); tv[i] = nok ? W[(size_t)(k0 + kk) * N + nn] : 0.f; }
    if (kscale) {
#pragma unroll
        for (int i = 0; i < 32; ++i) tv[i] *= kscale[k0 + 2 * i + (lane >> 5)];
    }
#pragma unroll
    for (int i = 0; i < 32; ++i) { const int kk = 2 * i + (lane >> 5); scr[kk * 33 + (lane & 31)] = tv[i]; }
    asm volatile("s_waitcnt lgkmcnt(0)" ::: "memory");
    const int c = lane & 7;
#pragma unroll
    for (int j = 0; j < 4; ++j) { const int n = (lane >> 3) + 8 * j; const LAS float* s = scr + (8 * c) * 33 + n;
        if (n0 + n < N) { float cs; bf16_t* dst = tmap(mode, n0 + n, d0, d1, K, cs);
            u32x4 o; o.x = pk2(s[0 * 33] * cs, s[1 * 33] * cs); o.y = pk2(s[2 * 33] * cs, s[3 * 33] * cs); o.z = pk2(s[4 * 33] * cs, s[5 * 33] * cs); o.w = pk2(s[6 * 33] * cs, s[7 * 33] * cs);
            *(u32x4*)(dst + k0 + 8 * c) = o; } }
    asm volatile("s_waitcnt lgkmcnt(0)" ::: "memory");
}

__device__ __forceinline__ void rms_row_to_bf16(const float* xrow, const float* g, bf16_t* orow, int lane) {
    const f32x4* xr = (const f32x4*)xrow + lane; const f32x4* gr = (const f32x4*)g + lane;
    f32x4 v[8]; float s = 0.f;
#pragma unroll
    for (int j = 0; j < 8; ++j) { v[j] = xr[64 * j]; s += (v[j].x * v[j].x + v[j].y * v[j].y) + (v[j].z * v[j].z + v[j].w * v[j].w); }
    const float r = rsqrtf(wave_sum(s) * (1.f / DM) + EPS);
    u32x2* o8 = (u32x2*)orow + lane;
#pragma unroll
    for (int j = 0; j < 8; ++j) { const f32x4 gg = gr[64 * j]; u32x2 w; w.x = pk2(v[j].x * r * gg.x, v[j].y * r * gg.y); w.y = pk2(v[j].z * r * gg.z, v[j].w * r * gg.w); o8[64 * j] = w; }
}

__device__ __forceinline__ void sincos_acc(float ang, float& sn, float& cs) {
    const double a = (double)ang;
    const double kq = __builtin_rint(a * 0.63661977236758134308);
    double r = __builtin_fma(-kq, 1.5707963267948966192, a); r = __builtin_fma(-kq, 6.123233995736766036e-17, r);
    const double r2 = r * r;
    const double sp = r * (1.0 + r2 * (-1.0 / 6 + r2 * (1.0 / 120 + r2 * (-1.0 / 5040 + r2 * (1.0 / 362880 + r2 * (-1.0 / 39916800))))));
    const double cp = 1.0 + r2 * (-0.5 + r2 * (1.0 / 24 + r2 * (-1.0 / 720 + r2 * (1.0 / 40320 + r2 * (-1.0 / 3628800 + r2 * (1.0 / 479001600))))));
    const int q = (int)((long long)kq & 3);
    const double s_ = (q & 1) ? cp : sp, c_ = (q & 1) ? sp : cp;
    sn = (float)((q & 2) ? -s_ : s_);
    cs = (float)(((q + 1) & 2) ? -c_ : c_);
}

#define MAX2(a, b) __builtin_amdgcn_fmed3f((a), (b), big_)
struct AttnPtrs { const bf16_t* Q; const bf16_t* PROJ; const bf16_t* KN; const bf16_t* KPE; const bf16_t* VT; const float* CL; bf16_t* O; };
template <bool MLA, bool grpB>
__device__ __forceinline__ void attn_unit_g(LAS unsigned char* lds, const AttnPtrs& P, int b, int h, int qblk) {
    constexpr int D = MLA ? 192 : 128, ND0 = D / 16, KROW = D * 2, KTILE = 64 * KROW, KSLOT = KTILE + 256, VROW = 128, VTILE = 128 * VROW, VBASE = 4 * KSLOT;
    constexpr int KCH = KTILE / 1024, KCH_W = (KCH + 7) / 8;
    int tid_ = threadIdx.x; asm volatile("" : "+v"(tid_));
    const int tid = tid_, lane = tid & 63, wid = __builtin_amdgcn_readfirstlane(tid >> 6), r32 = lane & 31, hi = lane >> 5;
    const int q0 = qblk * 256 + wid * 32;
    const size_t tokb = (size_t)b * SEQ;
    const int ntile = 4 * qblk + 4, my_last = q0 >> 6;
    bf16x8 qf[ND0];
    if (MLA) {
        const bf16_t* qrow = P.Q + (tokb + q0 + r32) * 1536;
#pragma unroll
        for (int d0 = 0; d0 < 8; ++d0) qf[d0] = *(const bf16x8*)(qrow + h * 128 + 16 * d0 + 8 * hi);
#pragma unroll
        for (int d0 = 8; d0 < ND0; ++d0) qf[d0] = *(const bf16x8*)(qrow + 1024 + h * 64 + 16 * (d0 - 8) + 8 * hi);
    } else {
        const bf16_t* qrow = P.PROJ + (tokb + q0 + r32) * NPROJ + PC_FQ + h * 128;
#pragma unroll
        for (int d0 = 0; d0 < ND0; ++d0) qf[d0] = *(const bf16x8*)(qrow + 16 * d0 + 8 * hi);
    }
    const float* clrow = P.CL + ((size_t)b * NH + h) * SEQ;
    const unsigned char* ksrc[KCH_W]; bool kok[KCH_W];
#pragma unroll
    for (int i = 0; i < KCH_W; ++i) {
        const int c = wid + 8 * i, s = c * 64 + lane; kok[i] = (c < KCH);
        if (MLA) { const int row = s / 24, sl = s - row * 24, g = ((row >> 1) & 3) | (((row >> 4) & 1) << 2), seg = (sl & 24) | ((sl ^ g) & 7);
            ksrc[i] = (seg < 16) ? (const unsigned char*)(P.KN + (tokb + row) * 1024 + h * 128 + seg * 8) : (const unsigned char*)(P.KPE + (tokb + row) * 64 + (seg - 16) * 8); }
        else { const int row = s >> 4, sl = s & 15, f = (row & 7) | (((row >> 4) & 1) << 3), seg = sl ^ f;
            ksrc[i] = (const unsigned char*)(P.PROJ + (tokb + row) * NPROJ + PC_FK + h * 128 + seg * 8); }
    }
    const unsigned char* vsrc[2];
#pragma unroll
    for (int i = 0; i < 2; ++i) { const int c = wid + 8 * i, s = c * 64 + lane, row = s >> 3, sl = s & 7, seg = sl ^ ((row >> 1) & 7);
        vsrc[i] = (const unsigned char*)(P.VT + (size_t)(h * 128 + row) * T + tokb + seg * 8); }
    const size_t kstep = MLA ? 0 : 0; (void)kstep;
    auto dma_k = [&](int j, int koff) {
#pragma unroll
        for (int i = 0; i < KCH_W; ++i) if (kok[i]) {
            size_t adv;
            if (MLA) { const int c = wid + 8 * i, s = c * 64 + lane, row = s / 24, sl = s - row * 24, g = ((row >> 1) & 3) | (((row >> 4) & 1) << 2), seg = (sl & 24) | ((sl ^ g) & 7);
                adv = (seg < 16) ? (size_t)64 * j * 1024 * 2 : (size_t)64 * j * 64 * 2; }
            else adv = (size_t)64 * j * NPROJ * 2;
            __builtin_amdgcn_global_load_lds((const unsigned*)(ksrc[i] + adv), (LAS unsigned*)(lds + koff + (wid + 8 * i) * 1024), 16, 0, 0); }
        if (!MLA) { if (wid == 7 && lane < 16) __builtin_amdgcn_global_load_lds((const unsigned*)(clrow + 64 * j + 4 * lane), (LAS unsigned*)(lds + koff + KTILE), 16, 0, 0); }
    };
    auto dma_v = [&](int j, int voff) {
#pragma unroll
        for (int i = 0; i < 2; ++i) __builtin_amdgcn_global_load_lds((const unsigned*)(vsrc[i] + (size_t)64 * j * 2), (LAS unsigned*)(lds + VBASE + voff + (wid + 8 * i) * 1024), 16, 0, 0);
    };
    f32x16 o[4];
#pragma unroll
    for (int i = 0; i < 4; ++i)
#pragma unroll
        for (int r = 0; r < 16; ++r) o[i][r] = 0.f;
    float lrun = 0.f;
    const int keyrow = 16 * ((r32 >> 2) & 1) + (r32 & 3) + 4 * (r32 >> 3);
    const int kswz = MLA ? (((keyrow >> 1) & 3) | (((keyrow >> 4) & 1) << 2)) : ((keyrow & 7) | (((keyrow >> 4) & 1) << 3));
    const int karow = keyrow * KROW;
    const int vswz = (r32 >> 1) & 7;
    const int varow = VBASE + r32 * VROW;
    f32x16 sc[2];
    bf16x8 pb[2][2];
    constexpr int PFD = 6;
    auto qk = [&](int koff) {
        if (MLA) {
        } else {
#pragma unroll
            for (int blk = 0; blk < 2; ++blk)
#pragma unroll
                for (int g = 0; g < 4; ++g) { const f32x4 c4 = *(const LAS f32x4*)(lds + koff + KTILE + (32 * blk + 16 * hi + 4 * g) * 4);
#pragma unroll
                    for (int e = 0; e < 4; ++e) sc[blk][4 * g + e] = c4[e]; }
        }
        const LAS unsigned char* ka = lds + koff + karow;
        bf16x8 a[PFD];
        auto ld = [&](int i) -> bf16x8 {
            const int d0 = i >> 1, blk = i & 1, seg = 2 * d0;
            int so;
            if (MLA) so = (((seg + hi) & 24) | (((seg + hi) ^ kswz) & 7)) * 16; else so = ((seg + hi) ^ kswz) * 16;
            return *(const LAS bf16x8*)(ka + blk * 32 * KROW + so);
        };
#pragma unroll
        for (int i = 0; i < PFD; ++i) a[i] = ld(i);
#pragma unroll
        for (int i = 0; i < 2 * ND0; ++i) {
            const f32x16 zc = {0.f, 0.f, 0.f, 0.f, 0.f, 0.f, 0.f, 0.f, 0.f, 0.f, 0.f, 0.f, 0.f, 0.f, 0.f, 0.f};
            sc[i & 1] = __builtin_amdgcn_mfma_f32_32x32x16_bf16(a[i % PFD], qf[i >> 1], (MLA && i < 2) ? zc : sc[i & 1], 0, 0, 0);
            if (i + PFD < 2 * ND0) a[i % PFD] = ld(i + PFD);
        }
        __builtin_amdgcn_sched_group_barrier(0x100, PFD, 0);
#pragma unroll
        for (int i = 0; i < 2 * ND0; ++i) { __builtin_amdgcn_sched_group_barrier(0x008, 1, 0); __builtin_amdgcn_sched_group_barrier(0x100, 1, 0); }
        __builtin_amdgcn_sched_barrier(0);
    };
    float mref = -1e30f;
    auto sm = [&](int j) {
        if (j >= my_last) {
            if (MLA) { if (j > my_last) {
#pragma unroll
                for (int r = 0; r < 16; ++r) { sc[0][r] = -2e30f; sc[1][r] = -2e30f; } } }
            else { const int qpos = q0 + r32;
#pragma unroll
                for (int blk = 0; blk < 2; ++blk)
#pragma unroll
                    for (int r = 0; r < 16; ++r) { const int key = 64 * j + 32 * blk + 16 * hi + r; if (key > qpos) sc[blk][r] = -2e30f; } }
        }
        float big_ = 3.0e38f; asm volatile("" : "+v"(big_));
        float mxa = MAX2(sc[0][0], sc[0][1]), mxb = MAX2(sc[0][2], sc[0][3]), mxc = MAX2(sc[1][0], sc[1][1]), mxd = MAX2(sc[1][2], sc[1][3]);
#pragma unroll
        for (int r = 4; r < 16; r += 4) { mxa = MAX2(mxa, MAX2(sc[0][r], sc[0][r + 1])); mxb = MAX2(mxb, MAX2(sc[0][r + 2], sc[0][r + 3])); mxc = MAX2(mxc, MAX2(sc[1][r], sc[1][r + 1])); mxd = MAX2(mxd, MAX2(sc[1][r + 2], sc[1][r + 3])); }
        float mx = MAX2(MAX2(mxa, mxb), MAX2(mxc, mxd));
        mx = MAX2(mx, __shfl_xor(mx, 32));
        if (__any(mx > mref + 8.0f)) {
            const float mnew = fmaxf(mref, mx), f = __builtin_amdgcn_exp2f(mref - mnew);
            mref = mnew; lrun *= f;
#pragma unroll
            for (int i = 0; i < 4; ++i)
#pragma unroll
                for (int r = 0; r < 16; ++r) o[i][r] *= f;
        }
        float ps = 0.f;
#pragma unroll
        for (int blk = 0; blk < 2; ++blk)
#pragma unroll
            for (int r = 0; r < 16; ++r) { const float pv_ = __builtin_amdgcn_exp2f(sc[blk][r] - mref); sc[blk][r] = pv_; ps += pv_; }
        lrun += ps;
#pragma unroll
        for (int blk = 0; blk < 2; ++blk)
#pragma unroll
            for (int ks = 0; ks < 2; ++ks) { u32x4 w;
                w.x = pg8::cvt_pk_bf16(sc[blk][8 * ks + 0], sc[blk][8 * ks + 1]); w.y = pg8::cvt_pk_bf16(sc[blk][8 * ks + 2], sc[blk][8 * ks + 3]);
                w.z = pg8::cvt_pk_bf16(sc[blk][8 * ks + 4], sc[blk][8 * ks + 5]); w.w = pg8::cvt_pk_bf16(sc[blk][8 * ks + 6], sc[blk][8 * ks + 7]);
                pb[blk][ks] = __builtin_bit_cast(bf16x8, w); }
        __builtin_amdgcn_sched_barrier(0);
    };
    auto pv = [&](int voff) {
        const LAS unsigned char* va = lds + varow + voff;
        bf16x8 a[PFD];
        auto ld = [&](int i) -> bf16x8 {
            const int dvb = i & 3, bk = i >> 2, so = ((4 * (bk >> 1) + 2 * hi + (bk & 1)) ^ vswz) * 16;
            return *(const LAS bf16x8*)(va + 32 * dvb * VROW + so);
        };
#pragma unroll
        for (int i = 0; i < PFD; ++i) a[i] = ld(i);
#pragma unroll
        for (int i = 0; i < 16; ++i) {
            o[i & 3] = __builtin_amdgcn_mfma_f32_32x32x16_bf16(a[i % PFD], pb[i >> 3][(i >> 2) & 1], o[i & 3], 0, 0, 0);
            if (i + PFD < 16) a[i % PFD] = ld(i + PFD);
        }
        __builtin_amdgcn_sched_group_barrier(0x100, PFD, 0);
#pragma unroll
        for (int i = 0; i < 16; ++i) { __builtin_amdgcn_sched_group_barrier(0x008, 1, 0); __builtin_amdgcn_sched_group_barrier(0x100, 1, 0); }
        __builtin_amdgcn_sched_barrier(0);
    };
    int k0 = 0, knext = KSLOT, k2 = 2 * KSLOT, k3 = 3 * KSLOT, vcur = 0, v1 = VTILE, v2 = 2 * VTILE;
    const int jl = ntile - 1;
    dma_k(jl, 0); dma_v(jl, 0); dma_k(jl - 1, KSLOT);
    dma_k(jl - 2, 2 * KSLOT); dma_v(jl - 1, VTILE);
    if (MLA) asm volatile("s_waitcnt vmcnt(5)\n\ts_barrier" ::: "memory"); else asm volatile("s_waitcnt vmcnt(4)\n\ts_barrier" ::: "memory");
    if (grpB) qk(0);
    for (int j = jl; j >= 0; --j) {
        if (j >= 3) dma_k(j - 3, k3);
        if (j >= 2) dma_v(j - 2, v2);
        if (!grpB) { if (j <= my_last) { qk(k0); sm(j); pv(vcur); } }
        else { if (j <= my_last) { sm(j); pv(vcur); } if (j > 0 && j - 1 <= my_last) qk(knext); }
        if (j >= 3) { if (MLA) asm volatile("s_waitcnt vmcnt(5) lgkmcnt(0)\n\ts_barrier" ::: "memory"); else asm volatile("s_waitcnt vmcnt(4) lgkmcnt(0)\n\ts_barrier" ::: "memory"); }
        else if (j == 2) asm volatile("s_waitcnt vmcnt(2) lgkmcnt(0)\n\ts_barrier" ::: "memory");
        else asm volatile("s_waitcnt vmcnt(0) lgkmcnt(0)\n\ts_barrier" ::: "memory");
        { const int t = k0; k0 = knext; knext = k2; k2 = k3; k3 = t; const int tv = vcur; vcur = v1; v1 = v2; v2 = tv; }
    }
    const float ltot = lrun + __shfl_xor(lrun, 32);
    const float inv = 1.0f / ltot;
    bf16_t* orow = P.O + (tokb + q0 + r32) * 1024 + h * 128;
#pragma unroll
    for (int dvb = 0; dvb < 4; ++dvb)
#pragma unroll
        for (int g = 0; g < 4; ++g) { u32x2 w; w.x = pg8::cvt_pk_bf16(o[dvb][4 * g] * inv, o[dvb][4 * g + 1] * inv); w.y = pg8::cvt_pk_bf16(o[dvb][4 * g + 2] * inv, o[dvb][4 * g + 3] * inv);
            *(u32x2*)(orow + 32 * dvb + 8 * g + 4 * hi) = w; }
}
template <bool MLA>
__device__ __forceinline__ void attn_unit(LAS unsigned char* lds, const AttnPtrs& P, int b, int h, int qblk) {
    if (__builtin_amdgcn_readfirstlane(threadIdx.x >> 6) < 4) attn_unit_g<MLA, false>(lds, P, b, h, qblk);
    else attn_unit_g<MLA, true>(lds, P, b, h, qblk);
}

#define XB_TMO      128
#define XB_XCNT(j)  (256  + 64 * (j))
#define XB_XSUB(j)  (1280 + 64 * (j))
#define XB_XGEN(j)  (2304 + 64 * (j))
#define XB_TOP      3328
#define XB_TOPGEN   3392
#define XCD_BAR_WORDS 3456
#define XB_SPIN_CAP (1u << 18)

__device__ __forceinline__ unsigned xb_ld(unsigned* p)              { return __hip_atomic_load(p, __ATOMIC_RELAXED, __HIP_MEMORY_SCOPE_AGENT); }
__device__ __forceinline__ unsigned xb_add(unsigned* p, unsigned v) { return __hip_atomic_fetch_add(p, v, __ATOMIC_RELAXED, __HIP_MEMORY_SCOPE_AGENT); }
__device__ __forceinline__ unsigned xb_xcc_id() { return (unsigned)__builtin_amdgcn_s_getreg((3 << 11) | 20) & 0xFu; }
#define XB_SPIN(cond, bar) do { unsigned _sp = 0; while (cond) { __builtin_amdgcn_s_sleep(1); \
    if ((++_sp & 255u) == 0u) { if (xb_ld(&(bar)[XB_TMO])) break; if (_sp > XB_SPIN_CAP) { atomicAdd(&(bar)[XB_TMO], 1u); break; } } } } while (0)

struct XcdBarrier {
    unsigned* bar; unsigned x;
    volatile LAS unsigned* st;
};

__device__ __forceinline__ XcdBarrier xcd_barrier_post(unsigned* bar, volatile LAS unsigned* st) {
    XcdBarrier b; b.bar = bar; b.x = xb_xcc_id(); b.st = st;
    if (threadIdx.x == 0) (void)xb_add(&bar[XB_XCNT(b.x)], 1u);
    return b;
}
__device__ __forceinline__ void xcd_barrier_complete(unsigned* bar, unsigned x, unsigned& nloc, unsigned& nx) {
    const unsigned G = gridDim.x * gridDim.y * gridDim.z;
    unsigned sum, cnt, mine, sp = 0u;
    for (;;) {
        sum = 0u; cnt = 0u; mine = 0u;
#pragma unroll
        for (unsigned j = 0; j < 16; ++j) { const unsigned c = xb_ld(&bar[XB_XCNT(j)]); sum += c; cnt += (c > 0u) ? 1u : 0u; mine = (j == x) ? c : mine; }
        if (sum == G) break;
        __builtin_amdgcn_s_sleep(1);
        if ((++sp & 255u) == 0u) { if (xb_ld(&bar[XB_TMO])) break; if (sp > XB_SPIN_CAP) { atomicAdd(&bar[XB_TMO], 1u); break; } }
    }
    nloc = mine > 0u ? mine : 1u; nx = cnt > 0u ? cnt : 1u;
}

__device__ __forceinline__ void xcd_barrier(const XcdBarrier& b) {
    asm volatile("s_waitcnt vmcnt(0)" ::: "memory");
    __syncthreads();
    if (threadIdx.x == 0) {
        unsigned* bar = b.bar;
        __builtin_amdgcn_s_waitcnt(0);
        unsigned nloc = b.st[0], nx = b.st[1];
        if (nloc == 0u) { xcd_barrier_complete(bar, b.x, nloc, nx); b.st[0] = nloc; b.st[1] = nx; }
        const unsigned old = xb_add(&bar[XB_XSUB(b.x)], 1u);
        const unsigned gen = old / nloc;
        if (old + 1u == (gen + 1u) * nloc) {
            __builtin_amdgcn_fence(__ATOMIC_RELEASE, "agent");
            asm volatile("s_waitcnt vmcnt(0)" ::: "memory");
            const unsigned og = xb_add(&bar[XB_TOP], 1u);
            const unsigned tg = og / nx;
            if (og + 1u == (tg + 1u) * nx) xb_add(&bar[XB_TOPGEN], 1u);
            else XB_SPIN(xb_ld(&bar[XB_TOPGEN]) == tg, bar);
            __builtin_amdgcn_fence(__ATOMIC_ACQUIRE, "agent");
            xb_add(&bar[XB_XGEN(b.x)], 1u);
            asm volatile("s_waitcnt vmcnt(0)" ::: "memory");
        } else {
            XB_SPIN(xb_ld(&bar[XB_XGEN(b.x)]) == gen, bar);
            __builtin_amdgcn_fence(__ATOMIC_ACQUIRE, "agent");
            asm volatile("s_waitcnt vmcnt(0)" ::: "memory");
        }
    }
    __syncthreads();
}


#ifndef MLA_REPS
#define MLA_REPS 1
#endif
#ifndef FOX_REPS
#define FOX_REPS 1
#endif
#ifndef ATTN_REPS
#define ATTN_REPS 1
#endif
#ifndef UP_REPS
#define UP_REPS 1
#endif
struct Args { const float* in[20]; float* out; unsigned char* ws; float inv_freq[32]; };
enum { I_X = 0, I_POS, I_PRE_MIX, I_WIN, I_QAN, I_WUQ, I_KVAN, I_WUKV, I_BFORGET, I_BGATE, I_WBM, I_WBF, I_WOUT, I_POST_MIX, I_PRE_FFN, I_WUP, I_CONVW, I_CONVB, I_WDOWN, I_POST_FFN };

__device__ __forceinline__ float gelu_tanh(float x) {
    const float z = 0.7978845608028654f * (x + 0.044715f * x * x * x);
    return x * __builtin_amdgcn_rcpf(1.0f + __expf(-2.0f * z));
}

#define PTRS() \
    unsigned char* ws = a.ws; float* outp = a.out; asm volatile("" : "+s"(ws), "+s"(outp)); \
    const float* x = a.in[I_X]; (void)x; \
    bf16_t* Win_t = (bf16_t*)(ws + WS_WIN); bf16_t* Wv_t = (bf16_t*)(ws + WS_WV); bf16_t* Wuq_t = (bf16_t*)(ws + WS_WUQ); bf16_t* Wkn_t = (bf16_t*)(ws + WS_WKN); \
    bf16_t* Wvm_t = (bf16_t*)(ws + WS_WVM); bf16_t* Wbm_t = (bf16_t*)(ws + WS_WBM); bf16_t* Wbf_t = (bf16_t*)(ws + WS_WBF); bf16_t* Wout_t = (bf16_t*)(ws + WS_WOUT); \
    bf16_t* Wup_t = (bf16_t*)(ws + WS_WUP); bf16_t* Wdn_t = (bf16_t*)(ws + WS_WDN); \
    bf16_t* H = (bf16_t*)(ws + WS_H); bf16_t* PROJ = (bf16_t*)(ws + WS_PROJ); bf16_t* VTF = (bf16_t*)(ws + WS_VTF); \
    bf16_t* QN = (bf16_t*)(ws + WS_QN); bf16_t* KVN = (bf16_t*)(ws + WS_KVN); bf16_t* KPE = (bf16_t*)(ws + WS_KPE); \
    float* COS = (float*)(ws + WS_COS); float* SIN = (float*)(ws + WS_SIN); float* CL = (float*)(ws + WS_CL); \
    bf16_t* Q = (bf16_t*)(ws + WS_Q); bf16_t* KN = (bf16_t*)(ws + WS_KN); bf16_t* VTM = (bf16_t*)(ws + WS_VTM); \
    bf16_t* OM = (bf16_t*)outp; bf16_t* OF = (bf16_t*)((unsigned char*)outp + 64 * MiB); bf16_t* MERGED = (bf16_t*)((unsigned char*)outp + 128 * MiB); \
    bf16_t* Y = (bf16_t*)(ws + WS_Y); bf16_t* X1 = (bf16_t*)(ws + WS_X1); float* OUT = outp; \
    bf16_t* ACT = (bf16_t*)(ws + WS_ACT); bf16_t* FF = (bf16_t*)(ws + WS_FF); float* HU = (float*)(ws + WS_HU);

__global__ void __launch_bounds__(512, 2) mega_fwd(Args a) {
    extern __shared__ __attribute__((aligned(16))) unsigned char lds_raw[];
    LAS unsigned char* lds = (LAS unsigned char*)lds_raw;
    cg::grid_group grid = cg::this_grid();
    const int tid = threadIdx.x, lane = tid & 63, wave = __builtin_amdgcn_readfirstlane(tid >> 6);
    const int G = gridDim.x, bx = blockIdx.x;
    const int gw = bx * 8 + wave, NGW = G * 8;
    if (tid < 2) ((volatile LAS unsigned*)(lds + LDS_MISC))[tid] = 0u;
    __syncthreads();
    const XcdBarrier xbar = xcd_barrier_post((unsigned*)(a.ws + WS_BAR), (volatile LAS unsigned*)(lds + LDS_MISC));
    if (a.ws == nullptr) grid.sync();
    { PTRS();
    {
        LAS float* scr = (LAS float*)(lds + wave * 16384);
        constexpr int I0 = 251 * 32, I1 = 48 * 8, I2 = 64 * 4, I3 = 64 * 16, I4 = 64 * 16, I5 = 64 * 32, I6 = 352 * 32, I7 = 64 * 88;
        constexpr int NIT = I0 + I1 + I2 + I3 + I4 + I5 + I6 + I7;
        for (int it = gw; it < NIT; it += NGW) {
            int r = it;
            if (r < I0) { transpose_item(a.in[I_WIN], 2048, 8008, 1, nullptr, Win_t, Wv_t, scr, r, lane); continue; } r -= I0;
            if (r < I1) { transpose_item(a.in[I_WUQ], 512, 1536, 2, a.in[I_QAN], Wuq_t, nullptr, scr, r, lane); continue; } r -= I1;
            if (r < I2) { transpose_item(a.in[I_WUKV], 256, 2048, 3, a.in[I_KVAN], Wkn_t, Wvm_t, scr, r, lane); continue; } r -= I2;
            if (r < I3) { transpose_item(a.in[I_WBM], 1024, 2048, 0, nullptr, Wbm_t, nullptr, scr, r, lane); continue; } r -= I3;
            if (r < I4) { transpose_item(a.in[I_WBF], 1024, 2048, 0, nullptr, Wbf_t, nullptr, scr, r, lane); continue; } r -= I4;
            if (r < I5) { transpose_item(a.in[I_WOUT], 2048, 2048, 0, nullptr, Wout_t, nullptr, scr, r, lane); continue; } r -= I5;
            if (r < I6) { transpose_item(a.in[I_WUP], 2048, DFF2, 4, nullptr, Wup_t, nullptr, scr, r, lane); continue; } r -= I6;
            transpose_item(a.in[I_WDOWN], DFF, 2048, 0, nullptr, Wdn_t, nullptr, scr, r, lane);
        }
        { u32x4* z = (u32x4*)(Win_t + (size_t)PC_END * 2048); const int nz = (NPROJ - PC_END) * 2048 / 8;
          for (int i = bx * 512 + tid; i < nz; i += G * 512) z[i] = (u32x4){0u, 0u, 0u, 0u}; }
        for (int m0 = gw * 2; m0 < T; m0 += NGW * 2) {
            f32x4 xv[2][8]; const f32x4* gr = (const f32x4*)a.in[I_PRE_MIX] + lane;
#pragma unroll
            for (int u = 0; u < 2; ++u) { const f32x4* xr = (const f32x4*)(x + (size_t)(m0 + u) * DM) + lane;
#pragma unroll
                for (int j = 0; j < 8; ++j) xv[u][j] = xr[64 * j]; }
#pragma unroll
            for (int u = 0; u < 2; ++u) { float s = 0.f;
#pragma unroll
                for (int j = 0; j < 8; ++j) { const f32x4 v = xv[u][j]; s += (v.x * v.x + v.y * v.y) + (v.z * v.z + v.w * v.w); }
                const float r = rsqrtf(wave_sum(s) * (1.f / DM) + EPS);
                u32x2* o8 = (u32x2*)(H + (size_t)(m0 + u) * DM) + lane;
#pragma unroll
                for (int j = 0; j < 8; ++j) { const f32x4 v = xv[u][j], gg = gr[64 * j]; u32x2 w; w.x = pk2(v.x * r * gg.x, v.y * r * gg.y); w.y = pk2(v.z * r * gg.z, v.w * r * gg.w); o8[64 * j] = w; }
            }
        }
        const int* pos = (const int*)a.in[I_POS];
        for (int i = bx * 512 + tid; i < T * 32; i += G * 512) { const int tk = i >> 5, fi = i & 31; const float ang = (float)pos[tk] * a.inv_freq[fi]; float sn, cs; sincos_acc(ang, sn, cs); COS[i] = cs; SIN[i] = sn; }
    }
    }
    xcd_barrier(xbar);


    { PTRS();
    {
        pg8::Gemm g{H, Win_t, T, NPROJ, DM}; pg8::StaticOrder S; S.init(T, NPROJ, G, bx);
        pg8::Epi<1> E{PROJ, NPROJ, a.in[I_BGATE], nullptr, 0, nullptr, nullptr, 16, lds + LDS_STG};
        pg8::gemm_phase<pg8::Epi<1>, pg8::StaticOrder, true, true>(lds, g, S, E);
    }
    {
        pg8::Gemm g{Wv_t, H, 1024, T, DM}; pg8::StaticOrder S; S.init(1024, T, G, bx);
        pg8::Epi<0> E{VTF, T, nullptr, nullptr, 0, nullptr, nullptr, 0, lds + LDS_STG};
        pg8::gemm_phase<pg8::Epi<0>, pg8::StaticOrder, true, true>(lds, g, S, E);
    }
    }
    xcd_barrier(xbar);

    { PTRS();
    for (int m0 = gw * 4; m0 < T; m0 += NGW * 4) {
        u32x4 wq[4]; u32x2 wk[4]; float k1[4], k2[4], cc[4], ss[4];
#pragma unroll
        for (int u = 0; u < 4; ++u) { const bf16_t* pr = PROJ + (size_t)(m0 + u) * NPROJ;
            wq[u] = *(const u32x4*)(pr + PC_QLAT + 8 * lane); wk[u] = *(const u32x2*)(pr + PC_KVLAT + 4 * lane);
            k1[u] = bf1(pr[PC_KPE + (lane & 31)]); k2[u] = bf1(pr[PC_KPE + 32 + (lane & 31)]); cc[u] = COS[(size_t)(m0 + u) * 32 + (lane & 31)]; ss[u] = SIN[(size_t)(m0 + u) * 32 + (lane & 31)]; }
#pragma unroll
        for (int u = 0; u < 4; ++u) { const int m = m0 + u;
            { const u32x4 w = wq[u];
              float v[8] = {bflo(w.x), bfhi(w.x), bflo(w.y), bfhi(w.y), bflo(w.z), bfhi(w.z), bflo(w.w), bfhi(w.w)}; float s = 0.f;
#pragma unroll
              for (int j = 0; j < 8; ++j) s += v[j] * v[j];
              const float r = rsqrtf(wave_sum(s) * (1.f / 512) + EPS);
              u32x4 o; o.x = pk2(v[0] * r, v[1] * r); o.y = pk2(v[2] * r, v[3] * r); o.z = pk2(v[4] * r, v[5] * r); o.w = pk2(v[6] * r, v[7] * r);
              *(u32x4*)(QN + (size_t)m * 512 + 8 * lane) = o; }
            { const u32x2 w = wk[u];
              float v[4] = {bflo(w.x), bfhi(w.x), bflo(w.y), bfhi(w.y)}; float s = (v[0] * v[0] + v[1] * v[1]) + (v[2] * v[2] + v[3] * v[3]);
              const float r = rsqrtf(wave_sum(s) * (1.f / 256) + EPS);
              u32x2 o; o.x = pk2(v[0] * r, v[1] * r); o.y = pk2(v[2] * r, v[3] * r);
              *(u32x2*)(KVN + (size_t)m * 256 + 4 * lane) = o; }
            if (lane < 32) { const int p1 = 8 * (lane >> 2) + (lane & 3);
              KPE[(size_t)m * 64 + p1] = (bf16_t)f2bf(k1[u] * cc[u] - k2[u] * ss[u]); KPE[(size_t)m * 64 + p1 + 4] = (bf16_t)f2bf(k2[u] * cc[u] + k1[u] * ss[u]); }
        }
    }
#ifndef NO_SCAN
    for (int bh = gw; bh < NB * NH; bh += NGW) {
        const int b = bh >> 3, hh = bh & 7; const float bfg = a.in[I_BFORGET][hh];
        float lf[32]; float run = 0.f;
#pragma unroll
        for (int i = 0; i < 32; ++i) { const float f = bf1(PROJ[((size_t)b * SEQ + 32 * lane + i) * NPROJ + PC_FLOG + hh]) + bfg; run += -logf(1.0f + expf(-f)); lf[i] = run; }
        float incl = run;
#pragma unroll
        for (int o = 1; o < 64; o <<= 1) { const float t = __shfl_up(incl, o); if (lane >= o) incl += t; }
        const float base = incl - run;
#pragma unroll
        for (int i = 0; i < 32; ++i) CL[(size_t)bh * SEQ + 32 * lane + i] = -(base + lf[i]) * LOG2E;
    }
#endif
    }
    xcd_barrier(xbar);

    { PTRS();
    {
        pg8::Gemm g{QN, Wuq_t, T, 1536, 512}; pg8::StaticOrder S; S.init(T, 1536, G, bx);
        pg8::Epi<2> E{Q, 1536, nullptr, nullptr, 0, COS, SIN, 4, lds + LDS_STG};
        pg8::gemm_phase<pg8::Epi<2>, pg8::StaticOrder, true, true>(lds, g, S, E);
    }
    {
        pg8::Gemm g{KVN, Wkn_t, T, 1024, 256}; pg8::StaticOrder S; S.init(T, 1024, G, bx);
        pg8::Epi<0> E{KN, 1024, nullptr, nullptr, 0, nullptr, nullptr, 0, lds + LDS_STG};
        pg8::gemm_phase<pg8::Epi<0>, pg8::StaticOrder, true, true>(lds, g, S, E);
    }
    {
        pg8::Gemm g{Wvm_t, KVN, 1024, T, 256}; pg8::StaticOrder S; S.init(1024, T, G, bx);
        pg8::Epi<0> E{VTM, T, nullptr, nullptr, 0, nullptr, nullptr, 0, lds + LDS_STG};
        pg8::gemm_phase<pg8::Epi<0>, pg8::StaticOrder, true, true>(lds, g, S, E);
    }
    }
    xcd_barrier(xbar);

    for (int rep_ = 0; rep_ < ATTN_REPS; ++rep_) { PTRS();
    {
        const AttnPtrs PM{Q, PROJ, KN, KPE, VTM, CL, OM};
        const AttnPtrs PF{Q, PROJ, KN, KPE, VTF, CL, OF};
        for (int rm_ = 0; rm_ < MLA_REPS; ++rm_)
        for (int idx = bx; idx < 1024; idx += G) {
            const int c = idx & 255, r = idx >> 8, bh = c >> 1;
            const int qb = (c & 1) ? ((r == 0) ? 2 : (r == 1) ? 5 : (r == 2) ? 3 : 4) : ((r == 0) ? 0 : (r == 1) ? 7 : (r == 2) ? 1 : 6);
#ifndef NO_MLA
            attn_unit<true>(lds, PM, bh >> 3, bh & 7, qb);
#endif
        }
        for (int rf_ = 0; rf_ < FOX_REPS; ++rf_)
        for (int idx = bx; idx < 1024; idx += G) {
            const int c = idx & 255, r = idx >> 8, bh = c >> 1;
            const int qb = (c & 1) ? ((r == 0) ? 2 : (r == 1) ? 5 : (r == 2) ? 3 : 4) : ((r == 0) ? 0 : (r == 1) ? 7 : (r == 2) ? 1 : 6);
#ifndef NO_FOX
            attn_unit<false>(lds, PF, bh >> 3, bh & 7, qb);
#endif
        }
    }
    }
    xcd_barrier(xbar);

    { PTRS();
    {
        pg8::Gemm g{OM, Wbm_t, T, DM, 1024}; pg8::StaticOrder S; S.init(T, DM, G, bx);
        pg8::Epi<3> E{MERGED, DM, nullptr, PROJ + PC_GATE, NPROJ, nullptr, nullptr, 0, lds + LDS_STG};
        pg8::gemm_phase<pg8::Epi<3>, pg8::StaticOrder, true, true>(lds, g, S, E);
    }
    {
        pg8::Gemm g{OF, Wbf_t, T, DM, 1024}; pg8::StaticOrder S; S.init(T, DM, G, bx);
        pg8::Epi<4> E{MERGED, DM, nullptr, PROJ + PC_GATE + 2048, NPROJ, nullptr, nullptr, 0, lds + LDS_STG};
        pg8::gemm_phase<pg8::Epi<4>, pg8::StaticOrder, true, true>(lds, g, S, E);
    }
    }
    xcd_barrier(xbar);

    { PTRS();
    {
        pg8::Gemm g{MERGED, Wout_t, T, DM, DM}; pg8::StaticOrder S; S.init(T, DM, G, bx);
        pg8::Epi<0> E{Y, DM, nullptr, nullptr, 0, nullptr, nullptr, 0, lds + LDS_STG};
        pg8::gemm_phase<pg8::Epi<0>, pg8::StaticOrder, true, true>(lds, g, S, E);
    }
    }
    xcd_barrier(xbar);

    { PTRS();
    const f32x4* g1 = (const f32x4*)a.in[I_POST_MIX] + lane; const f32x4* g2 = (const f32x4*)a.in[I_PRE_FFN] + lane;
    for (int m0 = gw * 2; m0 < T; m0 += NGW * 2) {
        u32x2 yw[2][8]; f32x4 xv[2][8];
#pragma unroll
        for (int u = 0; u < 2; ++u) { const u32x2* yr = (const u32x2*)(Y + (size_t)(m0 + u) * DM) + lane; const f32x4* xr = (const f32x4*)(x + (size_t)(m0 + u) * DM) + lane;
#pragma unroll
            for (int j = 0; j < 8; ++j) { yw[u][j] = yr[64 * j]; xv[u][j] = xr[64 * j]; } }
#pragma unroll
        for (int u = 0; u < 2; ++u) { const int m = m0 + u;
            f32x4 v[8]; float s = 0.f;
#pragma unroll
            for (int j = 0; j < 8; ++j) { const u32x2 w_ = yw[u][j]; v[j] = (f32x4){bflo(w_.x), bfhi(w_.x), bflo(w_.y), bfhi(w_.y)}; s += (v[j].x * v[j].x + v[j].y * v[j].y) + (v[j].z * v[j].z + v[j].w * v[j].w); }
            const float r = rsqrtf(wave_sum(s) * (1.f / DM) + EPS);
            float s2 = 0.f;
#pragma unroll
            for (int j = 0; j < 8; ++j) { v[j] = xv[u][j] + v[j] * r * g1[64 * j]; s2 += (v[j].x * v[j].x + v[j].y * v[j].y) + (v[j].z * v[j].z + v[j].w * v[j].w); }
            const float r2 = rsqrtf(wave_sum(s2) * (1.f / DM) + EPS);
            u32x2* xo = (u32x2*)(X1 + (size_t)m * DM) + lane; u32x2* ho = (u32x2*)(H + (size_t)m * DM) + lane;
#pragma unroll
            for (int j = 0; j < 8; ++j) { u32x2 xw; xw.x = pk2(v[j].x, v[j].y); xw.y = pk2(v[j].z, v[j].w); xo[64 * j] = xw; const f32x4 gg = g2[64 * j]; u32x2 w; w.x = pk2(v[j].x * r2 * gg.x, v[j].y * r2 * gg.y); w.y = pk2(v[j].z * r2 * gg.z, v[j].w * r2 * gg.w); ho[64 * j] = w; }
        }
    }
    }
    xcd_barrier(xbar);

    for (int rep_ = 0; rep_ < UP_REPS; ++rep_) { PTRS();
        pg8::Gemm g{H, Wup_t, T, DFF2, DM}; pg8::StaticOrder S; S.init(T, DFF2, G, bx);
        pg8::EpiConv E{ACT, HU, a.in[I_CONVW], a.in[I_CONVB], lds + 131072, DFF2 / 256, DFF};
        pg8::gemm_phase<pg8::EpiConv, pg8::StaticOrder, true, true>(lds, g, S, E);
    }
    xcd_barrier(xbar);
    { PTRS();
        const float* cw = a.in[I_CONVW]; const float* cb = a.in[I_CONVB];
        constexpr int NN = DFF2 / 256;
        for (int i = bx * 512 + tid; i < (T / 256) * NN * 32; i += G * 512) {
            const int c4 = (i & 31) * 4, pn = (i >> 5) % NN, pm = (i >> 5) / NN, ch0 = pn * 128 + c4;
            const bool first = (pm & 7) == 0;
            f32x4 tg[2], tv[2], pg[2], pv[2];
#pragma unroll
            for (int sl = 0; sl < 2; ++sl) {
                tg[sl] = *(const f32x4*)(HU + ((size_t)(pm * 4 + sl) * NN + pn) * 256 + c4); tv[sl] = *(const f32x4*)(HU + ((size_t)(pm * 4 + sl) * NN + pn) * 256 + 128 + c4);
                if (!first) { pg[sl] = *(const f32x4*)(HU + ((size_t)((pm - 1) * 4 + 2 + sl) * NN + pn) * 256 + c4); pv[sl] = *(const f32x4*)(HU + ((size_t)((pm - 1) * 4 + 2 + sl) * NN + pn) * 256 + 128 + c4); }
                else { pg[sl] = (f32x4){0.f, 0.f, 0.f, 0.f}; pv[sl] = pg[sl]; }
            }
            const f32x4 wg0 = *(const f32x4*)(cw + ch0), wg1 = *(const f32x4*)(cw + DFF2 + ch0), wg2 = *(const f32x4*)(cw + 2 * DFF2 + ch0);
            const f32x4 wv0 = *(const f32x4*)(cw + DFF + ch0), wv1 = *(const f32x4*)(cw + DFF2 + DFF + ch0), wv2 = *(const f32x4*)(cw + 2 * DFF2 + DFF + ch0);
            const f32x4 bg = *(const f32x4*)(cb + ch0), bv = *(const f32x4*)(cb + DFF + ch0);
            const f32x4 g_r0 = wg2 * tg[0] + wg1 * pg[1] + wg0 * pg[0] + bg, v_r0 = wv2 * tv[0] + wv1 * pv[1] + wv0 * pv[0] + bv;
            const f32x4 g_r1 = wg2 * tg[1] + wg1 * tg[0] + wg0 * pg[1] + bg, v_r1 = wv2 * tv[1] + wv1 * tv[0] + wv0 * pv[1] + bv;
            u32x2 w0, w1;
            w0.x = pk2(gelu_tanh(g_r0[0]) * v_r0[0], gelu_tanh(g_r0[1]) * v_r0[1]); w0.y = pk2(gelu_tanh(g_r0[2]) * v_r0[2], gelu_tanh(g_r0[3]) * v_r0[3]);
            w1.x = pk2(gelu_tanh(g_r1[0]) * v_r1[0], gelu_tanh(g_r1[1]) * v_r1[1]); w1.y = pk2(gelu_tanh(g_r1[2]) * v_r1[2], gelu_tanh(g_r1[3]) * v_r1[3]);
            *(u32x2*)(ACT + (size_t)(pm * 256) * DFF + ch0) = w0; *(u32x2*)(ACT + (size_t)(pm * 256 + 1) * DFF + ch0) = w1;
        }
    }
    xcd_barrier(xbar);
    { PTRS();
        pg8::Gemm g{ACT, Wdn_t, T, DM, DFF}; pg8::StaticOrder S; S.init(T, DM, G, bx);
        pg8::Epi<0> E{FF, DM, nullptr, nullptr, 0, nullptr, nullptr, 0, lds + LDS_STG};
        pg8::gemm_phase<pg8::Epi<0>, pg8::StaticOrder, true, true>(lds, g, S, E);
    }
    xcd_barrier(xbar);
    { PTRS();
        const f32x4* g1 = (const f32x4*)a.in[I_POST_FFN] + lane;
        for (int m0 = gw * 2; m0 < T; m0 += NGW * 2) {
            u32x2 fw[2][8]; u32x2 xv[2][8];
#pragma unroll
            for (int u = 0; u < 2; ++u) { const u32x2* fr_ = (const u32x2*)(FF + (size_t)(m0 + u) * DM) + lane; const u32x2* xr = (const u32x2*)(X1 + (size_t)(m0 + u) * DM) + lane;
#pragma unroll
                for (int j = 0; j < 8; ++j) { fw[u][j] = fr_[64 * j]; xv[u][j] = xr[64 * j]; } }
#pragma unroll
            for (int u = 0; u < 2; ++u) {
                f32x4 v[8]; float s = 0.f;
#pragma unroll
                for (int j = 0; j < 8; ++j) { const u32x2 w_ = fw[u][j]; v[j] = (f32x4){bflo(w_.x), bfhi(w_.x), bflo(w_.y), bfhi(w_.y)}; s += (v[j].x * v[j].x + v[j].y * v[j].y) + (v[j].z * v[j].z + v[j].w * v[j].w); }
                const float r = rsqrtf(wave_sum(s) * (1.f / DM) + EPS);
                f32x4* xo = (f32x4*)(OUT + (size_t)(m0 + u) * DM) + lane;
#pragma unroll
                for (int j = 0; j < 8; ++j) { const u32x2 xw = xv[u][j]; __builtin_nontemporal_store((f32x4){bflo(xw.x), bfhi(xw.x), bflo(xw.y), bfhi(xw.y)} + v[j] * r * g1[64 * j], &xo[64 * j]); }
            }
        }
    }
}

extern "C" void kernel_launch(void* const* d_in, const int* in_sizes, int n_in, void* d_out, int out_size, void* d_ws, size_t ws_size, hipStream_t stream) {
    static int grid = 0;
    if (grid == 0) {
        if (n_in != 20 || ws_size < WS_END) { fprintf(stderr, "kernel_launch: unexpected n_in %d / ws_size %zu\n", n_in, ws_size); grid = -1; return; }
        int dev = 0, cus = 0, per_cu = 0;
        hipGetDevice(&dev); hipDeviceGetAttribute(&cus, hipDeviceAttributeMultiprocessorCount, dev);
        hipFuncSetAttribute((const void*)mega_fwd, hipFuncAttributeMaxDynamicSharedMemorySize, LDS_BYTES);
        hipOccupancyMaxActiveBlocksPerMultiprocessor(&per_cu, (const void*)mega_fwd, 512, LDS_BYTES);
        if (per_cu < 1) { fprintf(stderr, "kernel_launch: occupancy query says %d blocks per CU\n", per_cu); per_cu = 1; }
        (void)hipGetLastError();
        grid = cus * per_cu;
        if (grid > 256) grid = 256;
    }
    if (grid < 0) return;
    Args a{};
    for (int i = 0; i < 20; ++i) a.in[i] = (const float*)d_in[i];
    a.out = (float*)d_out; a.ws = (unsigned char*)d_ws;
    for (int i = 0; i < 32; ++i) { const float p = (float)pow(10000.0, (double)(2 * i) / 64.0); a.inv_freq[i] = 1.0f / p; }
    void* args[] = {&a};
    (void)hipMemsetAsync((unsigned char*)d_ws + WS_BAR, 0, XCD_BAR_WORDS * 4, stream);
    hipError_t e = hipLaunchCooperativeKernel((const void*)mega_fwd, dim3(grid), dim3(512), args, LDS_BYTES, stream);
    if (e != hipSuccess) fprintf(stderr, "cooperative launch failed: %s (grid %d)\n", hipGetErrorString(e), grid);
}
```

```cpp
#include <hip/hip_runtime.h>
#include <hip/hip_cooperative_groups.h>
#include <cstdio>
#include <cstdint>
#include <cmath>
namespace cg = cooperative_groups;

namespace pg8 {
#define PG8_LAS __attribute__((address_space(3)))
typedef unsigned short bf16_t;
typedef short bf16x8 __attribute__((ext_vector_type(8)));
typedef float f32x4 __attribute__((ext_vector_type(4)));
typedef unsigned u32x4 __attribute__((ext_vector_type(4)));
constexpr int BM = 256, BK = 64, HALF = 128, HTB = HALF * BK * 2  , STAGE_BYTES = 8 * HTB, NXCD = 8, WGM = 8;

__host__ __device__ __forceinline__ int lds_byte(int r, int c) { const int st = (r >> 4) * 2 + (c >> 5), rr = r & 15, cc = c & 31, ob = rr * 64 + cc * 2; return st * 1024 + (ob ^ (((ob >> 9) & 1) << 5)); }
__host__ __device__ __forceinline__ void stage_rc(int b, int& R, int& C) { const int st = b / 1024, sb = b % 1024, swz = sb ^ (((sb >> 9) & 1) << 5); R = (st >> 1) * 16 + swz / 64; C = (st & 1) * 32 + (swz % 64) / 2; }
__host__ __device__ __forceinline__ int perm32(int rho) { const int n = rho >> 4, i = rho & 15; return 8 * (i >> 2) + 4 * n + (i & 3); }

struct Unit { int pm, pn; };
struct Gemm { const bf16_t* A; const bf16_t* Bt; int M, N, K; };

struct StaticOrder {
    int nM, nN, nwg, G, c;
    __host__ __device__ void init(int M, int N, int G_, int c_) { nM = M / BM; nN = N / BM; nwg = nM * nN; G = G_; c = c_; }
    __host__ __device__ bool next(int i, Unit& u) const {
        const long L = (long)i * G + c; if (L >= nwg) return false;
        int wgid = (int)L; { const int q = nwg / NXCD, r = nwg % NXCD, xcd = wgid % NXCD, off = wgid / NXCD; wgid = (xcd < r ? xcd * (q + 1) : r * (q + 1) + (xcd - r) * q) + off; }
        const int nig = WGM * nN, gid = wgid / nig, fm = gid * WGM, gsz = (nM - fm) < WGM ? (nM - fm) : WGM;
        u.pm = fm + ((wgid % nig) % gsz); u.pn = (wgid % nig) / gsz; return true;
    }
    __device__ __forceinline__ void a_ready(const Unit&) const {}
    __device__ __forceinline__ void done(const Unit&) const {}
};

__device__ __forceinline__ unsigned cvt_pk_bf16(float lo, float hi) { unsigned r; asm volatile("v_cvt_pk_bf16_f32 %0, %1, %2" : "=v"(r) : "v"(lo), "v"(hi)); return r; }
typedef unsigned u32x4 __attribute__((ext_vector_type(4)));
__device__ __forceinline__ float bf_lo(unsigned w) { return __uint_as_float(w << 16); }
__device__ __forceinline__ float bf_hi(unsigned w) { return __uint_as_float(w & 0xffff0000u); }
__device__ __forceinline__ float fsigmoid(float x) { return __builtin_amdgcn_rcpf(1.0f + __expf(-x)); }
#define GAS1 __attribute__((address_space(1)))
template <int MODE> struct Epi {
    static constexpr bool PERM = true, AFTER_DRAIN = false;
    void* O; int ldc; const float* bias; const bf16_t* G; int ldg; const float* cosT; const float* sinT; int ntile_special; PG8_LAS unsigned char* stg;
    __device__ __forceinline__ void operator()(const f32x4 (&acc)[2][2][4][2], const Unit& u, int wr, int wc, int fr, int fq) const {
        const int row0 = u.pm * BM + wr * 64 + fr, col0 = u.pn * BM + wc * 64 + 8 * fq;
        PG8_LAS unsigned char* sl = stg + (wr * 4 + wc) * 2304; const int L = fq * 16 + fr;
        const unsigned wa = (unsigned)(size_t)(sl + fr * 144 + fq * 16), ra = (unsigned)(size_t)(sl + (L >> 3) * 144 + (L & 7) * 16);
        const bool special = (MODE == 1) ? (u.pn < ntile_special) : (MODE == 2 ? (u.pn >= ntile_special) : false);
        u32x4 rb[2][2];
        bf16_t* obase = (bf16_t*)O + (size_t)(u.pm * BM + wr * 64 + (L >> 3)) * ldc + u.pn * BM + wc * 64 + 8 * (L & 7);
#pragma unroll
        for (int g = 0; g < 8; ++g) {
            const int ai = g >> 2, m = g & 3;
            const int row = row0 + ai * HALF + m * 16;
#pragma unroll
            for (int bj = 0; bj < 2; ++bj) {
                const int col = col0 + bj * 32;
                f32x4 v0 = acc[ai][bj][m][0], v1 = acc[ai][bj][m][1];
                if (MODE == 1) {
                    if (special) {
                        const f32x4 b0 = *(const GAS1 f32x4*)(bias + col) * -1.4426950408889634f, b1 = *(const GAS1 f32x4*)(bias + col + 4) * -1.4426950408889634f;
#pragma unroll
                        for (int j = 0; j < 4; ++j) { v0[j] = __builtin_amdgcn_rcpf(1.0f + __builtin_amdgcn_exp2f(__builtin_fmaf(v0[j], -1.4426950408889634f, b0[j])));
                                                      v1[j] = __builtin_amdgcn_rcpf(1.0f + __builtin_amdgcn_exp2f(__builtin_fmaf(v1[j], -1.4426950408889634f, b1[j]))); }
                    }
                }
                if (MODE == 2) {
                    if (special) {
                        const int fi = ((col & 63) >> 3) * 4;
                        const f32x4 c = *(const GAS1 f32x4*)(cosT + (size_t)row * 32 + fi), s_ = *(const GAS1 f32x4*)(sinT + (size_t)row * 32 + fi);
                        const f32x4 o1 = v0 * c - v1 * s_, o2 = v1 * c + v0 * s_; v0 = o1; v1 = o2;
                    }
                }
                if (MODE == 3 || MODE == 4) {
                    const u32x4 gw = *(const GAS1 u32x4*)(G + (size_t)row * ldg + col);
                    const f32x4 g0 = {bf_lo(gw.x), bf_hi(gw.x), bf_lo(gw.y), bf_hi(gw.y)}, g1 = {bf_lo(gw.z), bf_hi(gw.z), bf_lo(gw.w), bf_hi(gw.w)};
                    v0 = v0 * g0; v1 = v1 * g1;
                    if (MODE == 4) {
                        const u32x4 ow = *(const GAS1 u32x4*)((const bf16_t*)O + (size_t)row * ldc + col);
                        const f32x4 o0 = {bf_lo(ow.x), bf_hi(ow.x), bf_lo(ow.y), bf_hi(ow.y)}, o1 = {bf_lo(ow.z), bf_hi(ow.z), bf_lo(ow.w), bf_hi(ow.w)};
                        v0 += o0; v1 += o1;
                    }
                }
                u32x4 w; w.x = cvt_pk_bf16(v0[0], v0[1]); w.y = cvt_pk_bf16(v0[2], v0[3]); w.z = cvt_pk_bf16(v1[0], v1[1]); w.w = cvt_pk_bf16(v1[2], v1[3]);
                if (bj == 0) asm volatile("ds_write_b128 %0, %1" :: "v"(wa), "v"(w)); else asm volatile("ds_write_b128 %0, %1 offset:64" :: "v"(wa), "v"(w));
            }
            asm volatile("ds_read_b128 %0, %1" : "=&v"(rb[g & 1][0]) : "v"(ra));
            asm volatile("ds_read_b128 %0, %1 offset:1152" : "=&v"(rb[g & 1][1]) : "v"(ra));
            if (g >= 1) {
                asm volatile("s_waitcnt lgkmcnt(4)" : "+v"(rb[(g - 1) & 1][0]), "+v"(rb[(g - 1) & 1][1]));
                bf16_t* ob = obase + (size_t)(((g - 1) >> 2) * HALF + ((g - 1) & 3) * 16) * ldc;
                *(GAS1 u32x4*)ob = rb[(g - 1) & 1][0]; *(GAS1 u32x4*)(ob + (size_t)8 * ldc) = rb[(g - 1) & 1][1];
            }
        }
        asm volatile("s_waitcnt lgkmcnt(0)" : "+v"(rb[1][0]), "+v"(rb[1][1]));
        { bf16_t* ob = obase + (size_t)(HALF + 3 * 16) * ldc; *(GAS1 u32x4*)ob = rb[1][0]; *(GAS1 u32x4*)(ob + (size_t)8 * ldc) = rb[1][1]; }
    }
};


__device__ __forceinline__ float dpp_prev1(float prev, float cur) {
    const int t = __builtin_amdgcn_update_dpp(0, __builtin_bit_cast(int, prev), 0x121, 0xf, 0xf, false);
    return __builtin_bit_cast(float, __builtin_amdgcn_update_dpp(t, __builtin_bit_cast(int, cur), 0x111, 0xf, 0xf, false));
}
__device__ __forceinline__ float dpp_prev2(float prev, float cur) {
    const int t = __builtin_amdgcn_update_dpp(0, __builtin_bit_cast(int, prev), 0x122, 0xf, 0xf, false);
    return __builtin_bit_cast(float, __builtin_amdgcn_update_dpp(t, __builtin_bit_cast(int, cur), 0x112, 0xf, 0xf, false));
}
__device__ __forceinline__ float gelu_tanh_f(float x) {
    const float q = __builtin_fmaf(x * x, -0.10294325f, -2.3022082f);
    return x * __builtin_amdgcn_rcpf(1.0f + __builtin_amdgcn_exp2f(x * q));
}
typedef _Float16 h2_t __attribute__((ext_vector_type(2)));
__device__ __forceinline__ h2_t pkh(float a, float b) { return __builtin_bit_cast(h2_t, __builtin_amdgcn_cvt_pkrtz(a, b)); }
__device__ __forceinline__ h2_t pkh_rn(float a, float b) { h2_t r; r.x = (_Float16)a; r.y = (_Float16)b; return r; }
__device__ __forceinline__ h2_t dpph1(h2_t prev, h2_t cur) {
    const int pi = __builtin_bit_cast(int, prev), t = __builtin_amdgcn_update_dpp(pi, pi, 0x121, 0xf, 0xf, false);
    return __builtin_bit_cast(h2_t, __builtin_amdgcn_update_dpp(t, __builtin_bit_cast(int, cur), 0x111, 0xf, 0xf, false));
}
__device__ __forceinline__ h2_t dpph2(h2_t prev, h2_t cur) {
    const int pi = __builtin_bit_cast(int, prev), t = __builtin_amdgcn_update_dpp(pi, pi, 0x122, 0xf, 0xf, false);
    return __builtin_bit_cast(h2_t, __builtin_amdgcn_update_dpp(t, __builtin_bit_cast(int, cur), 0x112, 0xf, 0xf, false));
}
typedef unsigned u32x2e __attribute__((ext_vector_type(2)));
struct EpiConv {
    static constexpr bool PERM = true, AFTER_DRAIN = false;
    bf16_t* ACT; float* HU; const float* cw; const float* cb; PG8_LAS unsigned char* hl; int nN; int dff;
    __device__ __forceinline__ int hidx(int ai, int wr, int wc, int slot, int bj, int fq, int n) const { return ((((((ai * 2 + wr) * 4 + wc) * 2 + slot) * 2 + bj) * 4 + fq) * 2 + n) * 16; }
    __device__ __forceinline__ void operator()(const f32x4 (&acc)[2][2][4][2], const Unit& u, int wr, int wc, int fr, int fq) const {
        if (fr >= 14) {
#pragma unroll
            for (int ai = 0; ai < 2; ++ai)
#pragma unroll
                for (int bj = 0; bj < 2; ++bj)
#pragma unroll
                    for (int n = 0; n < 2; ++n) *(PG8_LAS f32x4*)(hl + hidx(ai, wr, wc, fr - 14, bj, fq, n)) = acc[ai][bj][3][n];
            if (wr == 1) {
#pragma unroll
                for (int bj = 0; bj < 2; ++bj)
#pragma unroll
                    for (int n = 0; n < 2; ++n) *(f32x4*)(HU + ((size_t)(u.pm * 4 + 2 + (fr - 14)) * nN + u.pn) * 256 + 128 * bj + 32 * wc + 8 * fq + 4 * n) = acc[1][bj][3][n];
            }
        }
        if (fr < 2 && wr == 0) {
#pragma unroll
            for (int bj = 0; bj < 2; ++bj)
#pragma unroll
                for (int n = 0; n < 2; ++n) *(f32x4*)(HU + ((size_t)(u.pm * 4 + fr) * nN + u.pn) * 256 + 128 * bj + 32 * wc + 8 * fq + 4 * n) = acc[0][bj][0][n];
        }
        asm volatile("s_waitcnt lgkmcnt(0)" ::: "memory"); __builtin_amdgcn_s_barrier(); asm volatile("" ::: "memory");
        const int row0 = u.pm * BM + wr * 64 + fr;
        u32x2e res[2][4];
#pragma unroll
        for (int n = 0; n < 2; ++n) {
            const int ch0 = u.pn * 128 + wc * 32 + 8 * fq + 4 * n;
            const f32x4 wg0 = *(const f32x4*)(cw + ch0), wg1 = *(const f32x4*)(cw + 2 * dff + ch0), wg2 = *(const f32x4*)(cw + 4 * dff + ch0);
            const f32x4 wv0 = *(const f32x4*)(cw + dff + ch0), wv1 = *(const f32x4*)(cw + 3 * dff + ch0), wv2 = *(const f32x4*)(cw + 5 * dff + ch0);
            const f32x4 bg = *(const f32x4*)(cb + ch0), bv = *(const f32x4*)(cb + dff + ch0);
            h2_t wg0h[2], wg1h[2], wg2h[2], wv0h[2], wv1h[2], wv2h[2], bgh[2], bvh[2];
#pragma unroll
            for (int p = 0; p < 2; ++p) { wg0h[p] = pkh_rn(wg0[2 * p], wg0[2 * p + 1]); wg1h[p] = pkh_rn(wg1[2 * p], wg1[2 * p + 1]); wg2h[p] = pkh_rn(wg2[2 * p], wg2[2 * p + 1]);
                wv0h[p] = pkh_rn(wv0[2 * p], wv0[2 * p + 1]); wv1h[p] = pkh_rn(wv1[2 * p], wv1[2 * p + 1]); wv2h[p] = pkh_rn(wv2[2 * p], wv2[2 * p + 1]);
                bgh[p] = pkh_rn(bg[2 * p], bg[2 * p + 1]); bvh[p] = pkh_rn(bv[2 * p], bv[2 * p + 1]); }
#pragma unroll
            for (int ai = 0; ai < 2; ++ai) {
                f32x4 pg = {0.f, 0.f, 0.f, 0.f}, pv = pg;
                const bool has = !(ai == 0 && wr == 0);
                if (has && fr >= 14) { const int pai = (wr == 1) ? ai : ai - 1, pwr = (wr == 1) ? 0 : 1;
                    pg = *(const PG8_LAS f32x4*)(hl + hidx(pai, pwr, wc, fr - 14, 0, fq, n)); pv = *(const PG8_LAS f32x4*)(hl + hidx(pai, pwr, wc, fr - 14, 1, fq, n)); }
                h2_t qgh[2] = {pkh(pg[0], pg[1]), pkh(pg[2], pg[3])}, qvh[2] = {pkh(pv[0], pv[1]), pkh(pv[2], pv[3])};
#pragma unroll
                for (int m = 0; m < 4; ++m) {
                    const f32x4 cg = acc[ai][0][m][n], cv = acc[ai][1][m][n];
                    const h2_t cgh[2] = {pkh(cg[0], cg[1]), pkh(cg[2], cg[3])}, cvh[2] = {pkh(cv[0], cv[1]), pkh(cv[2], cv[3])};
                    float o[4];
#pragma unroll
                    for (int p = 0; p < 2; ++p) {
                        const h2_t g1 = dpph1(qgh[p], cgh[p]), g2 = dpph2(qgh[p], cgh[p]);
                        const h2_t v1 = dpph1(qvh[p], cvh[p]), v2 = dpph2(qvh[p], cvh[p]);
                        const h2_t gg = wg2h[p] * cgh[p] + wg1h[p] * g1 + wg0h[p] * g2 + bgh[p];
                        const h2_t vv = wv2h[p] * cvh[p] + wv1h[p] * v1 + wv0h[p] * v2 + bvh[p];
                        const h2_t q = gg * gg * (h2_t){(_Float16)-0.10294325f, (_Float16)-0.10294325f} + (h2_t){(_Float16)-2.3022082f, (_Float16)-2.3022082f};
                        const h2_t arg = gg * q;
                        h2_t ex; ex.x = __builtin_exp2f16(arg.x); ex.y = __builtin_exp2f16(arg.y);
                        const h2_t den = ex + (h2_t){(_Float16)1.0f, (_Float16)1.0f};
                        h2_t rc; rc.x = __builtin_amdgcn_rcph(den.x); rc.y = __builtin_amdgcn_rcph(den.y);
                        const h2_t og = gg * rc * vv;
                        o[2 * p] = (float)og.x; o[2 * p + 1] = (float)og.y;
                        qgh[p] = cgh[p]; qvh[p] = cvh[p];
                    }
                    u32x2e w; w.x = cvt_pk_bf16(o[0], o[1]); w.y = cvt_pk_bf16(o[2], o[3]);
                    if (n == 0) res[ai][m] = w;
                    else { u32x4 w4; w4.x = res[ai][m].x; w4.y = res[ai][m].y; w4.z = w.x; w4.w = w.y;
                           *(u32x4*)(ACT + (size_t)(row0 + ai * HALF + m * 16) * dff + ch0 - 4) = w4; }
                }
            }
        }
    }
};

template <class Epi, class Sched, bool ALIGN_EPI = false, bool SP2 = false>
__device__ __forceinline__ void gemm_phase(PG8_LAS unsigned char* lds, const Gemm g, const Sched& S, const Epi& E) {
    int tid_ = threadIdx.x; asm volatile("" : "+v"(tid_));
    const int tid = tid_, wid = __builtin_amdgcn_readfirstlane(tid >> 6), lane = tid & 63, wr = wid >> 2, wc = wid & 3, fr = lane & 15, fq = lane >> 4;
    const int K = g.K, nt = K / BK;
    unsigned voffA[2], voffB[2];
#pragma unroll
    for (int i = 0; i < 2; ++i) { int R, C; stage_rc(tid * 16 + i * 8192, R, C); const int Rb = Epi::PERM ? (64 * (R >> 5) + perm32(R & 31)) : R;
        voffA[i] = (unsigned)(R * K + C) * 2u; voffB[i] = (unsigned)(Rb * K + C) * 2u; }
    const size_t kstep = (size_t)(BK * 2);
    const size_t hstep = (size_t)HALF * K * 2;
    const size_t hstepB = Epi::PERM ? (size_t)32 * K * 2 : hstep;
    const size_t tstep = 2 * hstep;
    const unsigned ldsw = (unsigned)wid * 1024u;
    const int aoff = lds_byte(wr * 64 + fr, fq * 8), boff = lds_byte(wc * 32 + fr, fq * 8);
#define PG8_SA(b, h) (((b) * 2 + (h)) * HTB)
#define PG8_SB(b, h) ((4 + (b) * 2 + (h)) * HTB)
#define PG8_STAGE(bufoff, gbase, voff) do { _Pragma("unroll") for (int _i = 0; _i < 2; ++_i) \
        __builtin_amdgcn_global_load_lds((const unsigned*)((const char*)(gbase) + (voff)[_i]), (PG8_LAS unsigned*)(lds + (bufoff) + ldsw + _i * 8192), 16, 0, 0); } while (0)
#define PG8_LDA(dst, b, h) do { _Pragma("unroll") for (int m = 0; m < 4; ++m) _Pragma("unroll") for (int k = 0; k < 2; ++k) dst[m][k] = *(const PG8_LAS bf16x8*)(lds + PG8_SA(b, h) + aoff + m * 2048 + k * 1024); } while (0)
#define PG8_LDB(dst, b, h) do { _Pragma("unroll") for (int n = 0; n < 2; ++n) _Pragma("unroll") for (int k = 0; k < 2; ++k) dst[n][k] = *(const PG8_LAS bf16x8*)(lds + PG8_SB(b, h) + boff + n * 2048 + k * 1024); } while (0)
#define PG8_MMA(ai, bj, At, Bt) do { __builtin_amdgcn_s_setprio(1); _Pragma("unroll") for (int m = 0; m < 4; ++m) _Pragma("unroll") for (int n = 0; n < 2; ++n) _Pragma("unroll") for (int k = 0; k < 2; ++k) \
        acc[ai][bj][m][n] = __builtin_amdgcn_mfma_f32_16x16x32_bf16(Bt[n][k], At[m][k], acc[ai][bj][m][n], 0, 0, 0); __builtin_amdgcn_s_setprio(0); } while (0)
#define PG8_WAIT_V(n) asm volatile("s_waitcnt vmcnt(" #n ")" ::: "memory")
#define PG8_WAIT_L(n) asm volatile("s_waitcnt lgkmcnt(" #n ")" ::: "memory")
#define PG8_BAR __builtin_amdgcn_s_barrier()
#define PG8_SCHED __builtin_amdgcn_sched_barrier(0)
    Unit cur, nxt; int ui = 0;
    if (!S.next(0, cur)) return;
    f32x4 acc[2][2][4][2];
#pragma unroll
    for (int a = 0; a < 2; ++a)
#pragma unroll
        for (int b = 0; b < 2; ++b)
#pragma unroll
            for (int m = 0; m < 4; ++m)
#pragma unroll
                for (int n = 0; n < 2; ++n) acc[a][b][m][n] = (f32x4){0.f, 0.f, 0.f, 0.f};
    bf16x8 At[4][2], B0[2][2], B1[2][2];
    const char* cA = (const char*)g.A + (size_t)cur.pm * tstep; const char* cB = (const char*)g.Bt + (size_t)cur.pn * tstep;
    S.a_ready(cur);
    if constexpr (SP2) {
        PG8_STAGE(PG8_SB(0, 0), cB, voffB); PG8_STAGE(PG8_SB(0, 1), cB + hstepB, voffB); PG8_STAGE(PG8_SA(0, 0), cA, voffA); PG8_STAGE(PG8_SA(0, 1), cA + hstep, voffA);
        if (wr == 1) PG8_BAR;
        PG8_WAIT_V(2); PG8_BAR;
        PG8_STAGE(PG8_SB(1, 0), cB + kstep, voffB); PG8_STAGE(PG8_SA(1, 0), cA + kstep, voffA); PG8_STAGE(PG8_SB(1, 1), cB + hstepB + kstep, voffB);
        PG8_WAIT_V(6); PG8_BAR;
    } else {
        PG8_STAGE(PG8_SB(0, 0), cB, voffB); PG8_STAGE(PG8_SA(0, 0), cA, voffA); PG8_STAGE(PG8_SB(0, 1), cB + hstepB, voffB); PG8_STAGE(PG8_SA(0, 1), cA + hstep, voffA);
        if (wr == 1) PG8_BAR;
        PG8_WAIT_V(4); PG8_BAR;
        PG8_STAGE(PG8_SB(1, 0), cB + kstep, voffB); PG8_STAGE(PG8_SA(1, 0), cA + kstep, voffA); PG8_STAGE(PG8_SB(1, 1), cB + hstepB + kstep, voffB);
        PG8_WAIT_V(6); PG8_BAR;
    }
    for (;;) {
        const bool has_next = S.next(ui + 1, nxt);
        const char* nA = has_next ? (const char*)g.A + (size_t)nxt.pm * tstep : cA; const char* nB = has_next ? (const char*)g.Bt + (size_t)nxt.pn * tstep : cB;
        for (int t = 0; t < nt; t += 2) {
            const bool last = (t == nt - 2);
            const char* a1 = cA + (size_t)(t + 1) * kstep;
            const char* a2 = last ? nA : cA + (size_t)(t + 2) * kstep; const char* b2 = last ? nB : cB + (size_t)(t + 2) * kstep;
            const char* a3 = a2 + kstep; const char* b3 = b2 + kstep;
            if (last && has_next) S.a_ready(nxt);
            if constexpr (SP2) {
            PG8_LDB(B0, 0, 0); PG8_LDB(B1, 0, 1); PG8_SCHED; PG8_LDA(At, 0, 0); PG8_STAGE(PG8_SA(1, 1), a1 + hstep, voffA);
            PG8_WAIT_V(8); PG8_WAIT_L(0); PG8_BAR; PG8_MMA(0, 0, At, B0); PG8_MMA(0, 1, At, B1); PG8_BAR; PG8_SCHED;
            PG8_LDA(At, 0, 1); PG8_STAGE(PG8_SB(0, 0), b2, voffB); PG8_STAGE(PG8_SB(0, 1), b2 + hstepB, voffB); PG8_STAGE(PG8_SA(0, 0), a2, voffA);
            PG8_WAIT_V(8); PG8_WAIT_L(0); PG8_BAR; PG8_MMA(1, 0, At, B0); PG8_MMA(1, 1, At, B1); PG8_BAR; PG8_SCHED;
            PG8_LDB(B0, 1, 0); PG8_LDB(B1, 1, 1); PG8_SCHED; PG8_LDA(At, 1, 0); PG8_STAGE(PG8_SA(0, 1), a2 + hstep, voffA);
            PG8_WAIT_V(8); PG8_WAIT_L(0); PG8_BAR; PG8_MMA(0, 0, At, B0); PG8_MMA(0, 1, At, B1); PG8_BAR; PG8_SCHED;
            PG8_LDA(At, 1, 1); PG8_STAGE(PG8_SB(1, 0), b3, voffB); PG8_STAGE(PG8_SB(1, 1), b3 + hstepB, voffB); PG8_STAGE(PG8_SA(1, 0), a3, voffA);
            PG8_WAIT_V(8); PG8_WAIT_L(0); PG8_BAR; PG8_MMA(1, 0, At, B0); PG8_MMA(1, 1, At, B1); PG8_BAR; PG8_SCHED;
            } else {
            PG8_LDB(B0, 0, 0); PG8_SCHED; PG8_LDA(At, 0, 0); PG8_STAGE(PG8_SA(1, 1), a1 + hstep, voffA);
            PG8_WAIT_L(8); PG8_BAR; PG8_WAIT_L(0); PG8_MMA(0, 0, At, B0); PG8_BAR; PG8_SCHED;
            PG8_LDB(B1, 0, 1); PG8_STAGE(PG8_SB(0, 0), b2, voffB);
            PG8_BAR; PG8_WAIT_L(0); PG8_MMA(0, 1, At, B1); PG8_BAR;
            PG8_LDA(At, 0, 1); PG8_STAGE(PG8_SA(0, 0), a2, voffA);
            PG8_BAR; PG8_WAIT_L(0); PG8_MMA(1, 0, At, B0); PG8_BAR; PG8_SCHED;
            PG8_STAGE(PG8_SB(0, 1), b2 + hstepB, voffB);
            PG8_WAIT_V(6); PG8_BAR; PG8_MMA(1, 1, At, B1); PG8_BAR;
            PG8_LDB(B0, 1, 0); PG8_SCHED; PG8_LDA(At, 1, 0); PG8_STAGE(PG8_SA(0, 1), a2 + hstep, voffA);
            PG8_WAIT_L(8); PG8_BAR; PG8_WAIT_L(0); PG8_MMA(0, 0, At, B0); PG8_BAR; PG8_SCHED;
            PG8_LDB(B1, 1, 1); PG8_STAGE(PG8_SB(1, 0), b3, voffB);
            PG8_BAR; PG8_WAIT_L(0); PG8_MMA(0, 1, At, B1); PG8_BAR;
            PG8_LDA(At, 1, 1); PG8_STAGE(PG8_SA(1, 0), a3, voffA);
            PG8_BAR; PG8_WAIT_L(0); PG8_MMA(1, 0, At, B0); PG8_BAR; PG8_SCHED;
            PG8_STAGE(PG8_SB(1, 1), b3 + hstepB, voffB);
            PG8_WAIT_V(6); PG8_BAR; PG8_MMA(1, 1, At, B1); PG8_BAR;
            }
        }
        if constexpr (ALIGN_EPI) { if (wr == 0) PG8_BAR; }
        if constexpr (!Epi::AFTER_DRAIN) { E(acc, cur, wr, wc, fr, fq); S.done(cur); }
        if (!has_next) break;
#pragma unroll
        for (int a = 0; a < 2; ++a)
#pragma unroll
            for (int b = 0; b < 2; ++b)
#pragma unroll
                for (int m = 0; m < 4; ++m)
#pragma unroll
                    for (int n = 0; n < 2; ++n) acc[a][b][m][n] = (f32x4){0.f, 0.f, 0.f, 0.f};
        cur = nxt; cA = nA; cB = nB; ++ui;
        if constexpr (ALIGN_EPI) { if (wr == 1) PG8_BAR; }
    }
    PG8_WAIT_V(0);
    if constexpr (!ALIGN_EPI) { if (wr == 0) PG8_BAR; }
    PG8_BAR;
    if constexpr (Epi::AFTER_DRAIN) { E.fused(acc, cur, wr, wc, fr, fq, lds, wid, lane); S.done(cur); }
#undef PG8_SA
#undef PG8_SB
#undef PG8_STAGE
#undef PG8_LDA
#undef PG8_LDB
#undef PG8_MMA
#undef PG8_WAIT_V
#undef PG8_WAIT_L
#undef PG8_BAR
#undef PG8_SCHED
}
}

#include <type_traits>
#define LAS __attribute__((address_space(3)))
typedef unsigned short bf16_t;
typedef short bf16x8 __attribute__((ext_vector_type(8)));
typedef float f32x4 __attribute__((ext_vector_type(4)));
typedef float f32x16 __attribute__((ext_vector_type(16)));
typedef unsigned u32x4 __attribute__((ext_vector_type(4)));
typedef unsigned u32x2 __attribute__((ext_vector_type(2)));
constexpr int NB = 16, SEQ = 2048, T = NB * SEQ, DM = 2048, NH = 8;
constexpr int DFF = 5632, DFF2 = 2 * DFF;
constexpr int NPROJ = 7168;
constexpr int PC_GATE = 0, PC_FQ = 4096, PC_FK = 5120, PC_QLAT = 6144, PC_KVLAT = 6656, PC_KPE = 6912, PC_FLOG = 6976, PC_END = 6984;
constexpr float EPS = 1e-6f, LOG2E = 1.4426950408889634f;
constexpr int TH = T / 2;

constexpr size_t MiB = 1u << 20;
constexpr size_t WS_WIN = 0, WS_WV = 28 * MiB, WS_WUQ = 32 * MiB, WS_WKN = 34 * MiB, WS_WVM = 35 * MiB, WS_WBM = 36 * MiB, WS_WBF = 40 * MiB, WS_WOUT = 44 * MiB,
                 WS_WUP = 52 * MiB, WS_WDN = 96 * MiB;
constexpr size_t WS_H = 128 * MiB;
constexpr size_t WS_KN = 128 * MiB, WS_VTM = 192 * MiB;
constexpr size_t WS_PROJ = 256 * MiB;
constexpr size_t WS_Y = 256 * MiB;
constexpr size_t WS_ACT = 256 * MiB, WS_FF = 608 * MiB, WS_X1 = 736 * MiB, WS_HU = 864 * MiB;
constexpr size_t WS_VTF = 704 * MiB;
constexpr size_t WS_QN = 768 * MiB, WS_KVN = 800 * MiB, WS_KPE = 816 * MiB, WS_COS = 820 * MiB, WS_SIN = 824 * MiB, WS_CL = 828 * MiB;
constexpr size_t WS_Q = 832 * MiB;
constexpr size_t WS_BAR = 928 * MiB;
constexpr size_t WS_END = 929 * MiB;
constexpr int LDS_BYTES = 159744, LDS_HALO = 131072, LDS_STG = 139264, LDS_MISC = 158720;

__device__ __forceinline__ float wave_sum(float v) {
#pragma unroll
    for (int o = 1; o < 64; o <<= 1) v += __shfl_xor(v, o);
    return v;
}
__device__ __forceinline__ unsigned f2bf(float f) { unsigned u = __builtin_bit_cast(unsigned, f); return (u + 0x7fffu + ((u >> 16) & 1u)) >> 16; }
__device__ __forceinline__ unsigned pk2(float lo, float hi) { return f2bf(lo) | (f2bf(hi) << 16); }
__device__ __forceinline__ float bflo(unsigned w) { return __uint_as_float(w << 16); }
__device__ __forceinline__ float bfhi(unsigned w) { return __uint_as_float(w & 0xffff0000u); }
__device__ __forceinline__ float bf1(bf16_t h) { return __uint_as_float((unsigned)h << 16); }

__device__ __forceinline__ bf16_t* tmap(int mode, int n, bf16_t* d0, bf16_t* d1, int K, float& cs) {
    cs = 1.f;
    if (mode == 0) return d0 + (size_t)n * K;
    if (mode == 4) { const int g = (n >= DFF) ? 1 : 0, c = n - g * DFF; return d0 + (size_t)((c >> 7) * 256 + 64 * ((c & 127) >> 5) + 32 * g + (c & 31)) * K; }
    if (mode == 1) {
        int r;
        if (n < 512) r = PC_QLAT + n;
        else if (n < 768) r = PC_KVLAT + (n - 512);
        else if (n < 832) r = PC_KPE + (n - 768);
        else if (n < 1856) { r = PC_FQ + (n - 832); cs = 0.08838834764831845f * LOG2E; }
        else if (n < 2880) r = PC_FK + (n - 1856);
        else if (n < 3904) return d1 + (size_t)(n - 2880) * K;
        else if (n < 3912) r = PC_FLOG + (n - 3904);
        else r = PC_GATE + (n - 3912);
        return d0 + (size_t)r * K;
    }
    if (mode == 2) {
        cs = 0.07216878364870322f * LOG2E;
        const int hh = n / 192, d = n - hh * 192; int r;
        if (d < 128) r = hh * 128 + d;
        else { const int e = d - 128, i = e & 31, hf = e >> 5; r = 1024 + hh * 64 + 8 * (i >> 2) + 4 * hf + (i & 3); }
        return d0 + (size_t)r * K;
    }
    { const int hh = n >> 8, d = n & 255;
      if (d < 128) return d0 + (size_t)(hh * 128 + d) * K;
      return d1 + (size_t)(hh * 128 + d - 128) * K; }
}
__device__ __forceinline__ void transpose_item(const float* W, int K, int N, int mode, const float* kscale, bf16_t* d0, bf16_t* d1, LAS float* scr, int item, int lane) {
    const int nblk = (N + 31) / 32, kb = item / nblk, nb = item - kb * nblk, k0 = 64 * kb, n0 = 32 * nb;
    const int nn = n0 + (lane & 31); const bool nok = nn < N;
    float tv[32];
#pragma unroll
    for (int i = 0; i < 32; ++i) { const int kk = 2 * i + (lane >> 5); tv[i] = nok ? W[(size_t)(k0 + kk) * N + nn] : 0.f; }
    if (kscale) {
#pragma unroll
        for (int i = 0; i < 32; ++i) tv[i] *= kscale[k0 + 2 * i + (lane >> 5)];
    }
#pragma unroll
    for (int i = 0; i < 32; ++i) { const int kk = 2 * i + (lane >> 5); scr[kk * 33 + (lane & 31)] = tv[i]; }
    asm volatile("s_waitcnt lgkmcnt(0)" ::: "memory");
    const int c = lane & 7;
#pragma unroll
    for (int j = 0; j < 4; ++j) { const int n = (lane >> 3) + 8 * j; const LAS float* s = scr + (8 * c) * 33 + n;
        if (n0 + n < N) { float cs; bf16_t* dst = tmap(mode, n0 + n, d0, d1, K, cs);
            u32x4 o; o.x = pk2(s[0 * 33] * cs, s[1 * 33] * cs); o.y = pk2(s[2 * 33] * cs, s[3 * 33] * cs); o.z = pk2(s[4 * 33] * cs, s[5 * 33] * cs); o.w = pk2(s[6 * 33] * cs, s[7 * 33] * cs);
            *(u32x4*)(dst + k0 + 8 * c) = o; } }
    asm volatile("s_waitcnt lgkmcnt(0)" ::: "memory");
}

__device__ __forceinline__ void rms_row_to_bf16(const float* xrow, const float* g, bf16_t* orow, int lane) {
    const f32x4* xr = (const f32x4*)xrow + lane; const f32x4* gr = (const f32x4*)g + lane;
    f32x4 v[8]; float s = 0.f;
#pragma unroll
    for (int j = 0; j < 8; ++j) { v[j] = xr[64 * j]; s += (v[j].x * v[j].x + v[j].y * v[j].y) + (v[j].z * v[j].z + v[j].w * v[j].w); }
    const float r = rsqrtf(wave_sum(s) * (1.f / DM) + EPS);
    u32x2* o8 = (u32x2*)orow + lane;
#pragma unroll
    for (int j = 0; j < 8; ++j) { const f32x4 gg = gr[64 * j]; u32x2 w; w.x = pk2(v[j].x * r * gg.x, v[j].y * r * gg.y); w.y = pk2(v[j].z * r * gg.z, v[j].w * r * gg.w); o8[64 * j] = w; }
}

__device__ __forceinline__ void sincos_acc(float ang, float& sn, float& cs) {
    const double a = (double)ang;
    const double kq = __builtin_rint(a * 0.63661977236758134308);
    double r = __builtin_fma(-kq, 1.5707963267948966192, a); r = __builtin_fma(-kq, 6.123233995736766036e-17, r);
    const double r2 = r * r;
    const double sp = r * (1.0 + r2 * (-1.0 / 6 + r2 * (1.0 / 120 + r2 * (-1.0 / 5040 + r2 * (1.0 / 362880 + r2 * (-1.0 / 39916800))))));
    const double cp = 1.0 + r2 * (-0.5 + r2 * (1.0 / 24 + r2 * (-1.0 / 720 + r2 * (1.0 / 40320 + r2 * (-1.0 / 3628800 + r2 * (1.0 / 479001600))))));
    const int q = (int)((long long)kq & 3);
    const double s_ = (q & 1) ? cp : sp, c_ = (q & 1) ? sp : cp;
    sn = (float)((q & 2) ? -s_ : s_);
    cs = (float)(((q + 1) & 2) ? -c_ : c_);
}

#define MAX2(a, b) __builtin_amdgcn_fmed3f((a), (b), big_)
struct AttnPtrs { const bf16_t* Q; const bf16_t* PROJ; const bf16_t* KN; const bf16_t* KPE; const bf16_t* VT; const float* CL; bf16_t* O; };
template <bool MLA, bool grpB>
__device__ __forceinline__ void attn_unit_g(LAS unsigned char* lds, const AttnPtrs& P, int b, int h, int qblk) {
    constexpr int D = MLA ? 192 : 128, ND0 = D / 16, KROW = D * 2, KTILE = 64 * KROW, KSLOT = KTILE + 256, VROW = 128, VTILE = 128 * VROW, VBASE = 4 * KSLOT;
    constexpr int KCH = KTILE / 1024, KCH_W = (KCH + 7) / 8;
    int tid_ = threadIdx.x; asm volatile("" : "+v"(tid_));
    const int tid = tid_, lane = tid & 63, wid = __builtin_amdgcn_readfirstlane(tid >> 6), r32 = lane & 31, hi = lane >> 5;
    const int q0 = qblk * 256 + wid * 32;
    const size_t tokb = (size_t)b * SEQ;
    const int ntile = 4 * qblk + 4, my_last = q0 >> 6;
    bf16x8 qf[ND0];
    if (MLA) {
        const bf16_t* qrow = P.Q + (tokb + q0 + r32) * 1536;
#pragma unroll
        for (int d0 = 0; d0 < 8; ++d0) qf[d0] = *(const bf16x8*)(qrow + h * 128 + 16 * d0 + 8 * hi);
#pragma unroll
        for (int d0 = 8; d0 < ND0; ++d0) qf[d0] = *(const bf16x8*)(qrow + 1024 + h * 64 + 16 * (d0 - 8) + 8 * hi);
    } else {
        const bf16_t* qrow = P.PROJ + (tokb + q0 + r32) * NPROJ + PC_FQ + h * 128;
#pragma unroll
        for (int d0 = 0; d0 < ND0; ++d0) qf[d0] = *(const bf16x8*)(qrow + 16 * d0 + 8 * hi);
    }
    const float* clrow = P.CL + ((size_t)b * NH + h) * SEQ;
    const unsigned char* ksrc[KCH_W]; bool kok[KCH_W];
#pragma unroll
    for (int i = 0; i < KCH_W; ++i) {
        const int c = wid + 8 * i, s = c * 64 + lane; kok[i] = (c < KCH);
        if (MLA) { const int row = s / 24, sl = s - row * 24, g = ((row >> 1) & 3) | (((row >> 4) & 1) << 2), seg = (sl & 24) | ((sl ^ g) & 7);
            ksrc[i] = (seg < 16) ? (const unsigned char*)(P.KN + (tokb + row) * 1024 + h * 128 + seg * 8) : (const unsigned char*)(P.KPE + (tokb + row) * 64 + (seg - 16) * 8); }
        else { const int row = s >> 4, sl = s & 15, f = (row & 7) | (((row >> 4) & 1) << 3), seg = sl ^ f;
            ksrc[i] = (const unsigned char*)(P.PROJ + (tokb + row) * NPROJ + PC_FK + h * 128 + seg * 8); }
    }
    const unsigned char* vsrc[2];
#pragma unroll
    for (int i = 0; i < 2; ++i) { const int c = wid + 8 * i, s = c * 64 + lane, row = s >> 3, sl = s & 7, seg = sl ^ ((row >> 1) & 7);
        vsrc[i] = (const unsigned char*)(P.VT + (size_t)(h * 128 + row) * T + tokb + seg * 8); }
    const size_t kstep = MLA ? 0 : 0; (void)kstep;
    auto dma_k = [&](int j, int koff) {
#pragma unroll
        for (int i = 0; i < KCH_W; ++i) if (kok[i]) {
            size_t adv;
            if (MLA) { const int c = wid + 8 * i, s = c * 64 + lane, row = s / 24, sl = s - row * 24, g = ((row >> 1) & 3) | (((row >> 4) & 1) << 2), seg = (sl & 24) | ((sl ^ g) & 7);
                adv = (seg < 16) ? (size_t)64 * j * 1024 * 2 : (size_t)64 * j * 64 * 2; }
            else adv = (size_t)64 * j * NPROJ * 2;
            __builtin_amdgcn_global_load_lds((const unsigned*)(ksrc[i] + adv), (LAS unsigned*)(lds + koff + (wid + 8 * i) * 1024), 16, 0, 0); }
        if (!MLA) { if (wid == 7 && lane < 16) __builtin_amdgcn_global_load_lds((const unsigned*)(clrow + 64 * j + 4 * lane), (LAS unsigned*)(lds + koff + KTILE), 16, 0, 0); }
    };
    auto dma_v = [&](int j, int voff) {
#pragma unroll
        for (int i = 0; i < 2; ++i) __builtin_amdgcn_global_load_lds((const unsigned*)(vsrc[i] + (size_t)64 * j * 2), (LAS unsigned*)(lds + VBASE + voff + (wid + 8 * i) * 1024), 16, 0, 0);
    };
    f32x16 o[4];
#pragma unroll
    for (int i = 0; i < 4; ++i)
#pragma unroll
        for (int r = 0; r < 16; ++r) o[i][r] = 0.f;
    float lrun = 0.f;
    const int keyrow = 16 * ((r32 >> 2) & 1) + (r32 & 3) + 4 * (r32 >> 3);
    const int kswz = MLA ? (((keyrow >> 1) & 3) | (((keyrow >> 4) & 1) << 2)) : ((keyrow & 7) | (((keyrow >> 4) & 1) << 3));
    const int karow = keyrow * KROW;
    const int vswz = (r32 >> 1) & 7;
    const int varow = VBASE + r32 * VROW;
    f32x16 sc[2];
    bf16x8 pb[2][2];
    constexpr int PFD = 8;
    auto qk = [&](int koff) {
        if (MLA) {
        } else {
#pragma unroll
            for (int blk = 0; blk < 2; ++blk)
#pragma unroll
                for (int g = 0; g < 4; ++g) { const f32x4 c4 = *(const LAS f32x4*)(lds + koff + KTILE + (32 * blk + 16 * hi + 4 * g) * 4);
#pragma unroll
                    for (int e = 0; e < 4; ++e) sc[blk][4 * g + e] = c4[e]; }
        }
        const LAS unsigned char* ka = lds + koff + karow;
        bf16x8 a[PFD];
        auto ld = [&](int i) -> bf16x8 {
            const int d0 = i >> 1, blk = i & 1, seg = 2 * d0;
            int so;
            if (MLA) so = (((seg + hi) & 24) | (((seg + hi) ^ kswz) & 7)) * 16; else so = ((seg + hi) ^ kswz) * 16;
            return *(const LAS bf16x8*)(ka + blk * 32 * KROW + so);
        };
#pragma unroll
        for (int i = 0; i < PFD; ++i) a[i] = ld(i);
#pragma unroll
        for (int i = 0; i < 2 * ND0; ++i) {
            const f32x16 zc = {0.f, 0.f, 0.f, 0.f, 0.f, 0.f, 0.f, 0.f, 0.f, 0.f, 0.f, 0.f, 0.f, 0.f, 0.f, 0.f};
            sc[i & 1] = __builtin_amdgcn_mfma_f32_32x32x16_bf16(a[i % PFD], qf[i >> 1], (MLA && i < 2) ? zc : sc[i & 1], 0, 0, 0);
            if (i + PFD < 2 * ND0) a[i % PFD] = ld(i + PFD);
        }
        __builtin_amdgcn_sched_group_barrier(0x100, PFD, 0);
#pragma unroll
        for (int i = 0; i < 2 * ND0; ++i) { __builtin_amdgcn_sched_group_barrier(0x008, 1, 0); __builtin_amdgcn_sched_group_barrier(0x100, 1, 0); }
        __builtin_amdgcn_sched_barrier(0);
    };
    float mref = -1e30f;
    auto sm = [&](int j) {
        if (j >= my_last) {
            if (MLA) { if (j > my_last) {
#pragma unroll
                for (int r = 0; r < 16; ++r) { sc[0][r] = -2e30f; sc[1][r] = -2e30f; } } }
            else { const int qpos = q0 + r32;
#pragma unroll
                for (int blk = 0; blk < 2; ++blk)
#pragma unroll
                    for (int r = 0; r < 16; ++r) { const int key = 64 * j + 32 * blk + 16 * hi + r; if (key > qpos) sc[blk][r] = -2e30f; } }
        }
        float big_ = 3.0e38f; asm volatile("" : "+v"(big_));
        float mxa = MAX2(sc[0][0], sc[0][1]), mxb = MAX2(sc[0][2], sc[0][3]), mxc = MAX2(sc[1][0], sc[1][1]), mxd = MAX2(sc[1][2], sc[1][3]);
#pragma unroll
        for (int r = 4; r < 16; r += 4) { mxa = MAX2(mxa, MAX2(sc[0][r], sc[0][r + 1])); mxb = MAX2(mxb, MAX2(sc[0][r + 2], sc[0][r + 3])); mxc = MAX2(mxc, MAX2(sc[1][r], sc[1][r + 1])); mxd = MAX2(mxd, MAX2(sc[1][r + 2], sc[1][r + 3])); }
        float mx = MAX2(MAX2(mxa, mxb), MAX2(mxc, mxd));
        mx = MAX2(mx, __shfl_xor(mx, 32));
        if (__any(mx > mref + 8.0f)) {
            const float mnew = fmaxf(mref, mx), f = __builtin_amdgcn_exp2f(mref - mnew);
            mref = mnew; lrun *= f;
#pragma unroll
            for (int i = 0; i < 4; ++i)
#pragma unroll
                for (int r = 0; r < 16; ++r) o[i][r] *= f;
        }
        float ps = 0.f;
#pragma unroll
        for (int blk = 0; blk < 2; ++blk)
#pragma unroll
            for (int r = 0; r < 16; ++r) { const float pv_ = __builtin_amdgcn_exp2f(sc[blk][r] - mref); sc[blk][r] = pv_; ps += pv_; }
        lrun += ps;
#pragma unroll
        for (int blk = 0; blk < 2; ++blk)
#pragma unroll
            for (int ks = 0; ks < 2; ++ks) { u32x4 w;
                w.x = pg8::cvt_pk_bf16(sc[blk][8 * ks + 0], sc[blk][8 * ks + 1]); w.y = pg8::cvt_pk_bf16(sc[blk][8 * ks + 2], sc[blk][8 * ks + 3]);
                w.z = pg8::cvt_pk_bf16(sc[blk][8 * ks + 4], sc[blk][8 * ks + 5]); w.w = pg8::cvt_pk_bf16(sc[blk][8 * ks + 6], sc[blk][8 * ks + 7]);
                pb[blk][ks] = __builtin_bit_cast(bf16x8, w); }
        __builtin_amdgcn_sched_barrier(0);
    };
    auto pv = [&](int voff) {
        const LAS unsigned char* va = lds + varow + voff;
        bf16x8 a[PFD];
        auto ld = [&](int i) -> bf16x8 {
            const int dvb = i & 3, bk = i >> 2, so = ((4 * (bk >> 1) + 2 * hi + (bk & 1)) ^ vswz) * 16;
            return *(const LAS bf16x8*)(va + 32 * dvb * VROW + so);
        };
#pragma unroll
        for (int i = 0; i < PFD; ++i) a[i] = ld(i);
#pragma unroll
        for (int i = 0; i < 16; ++i) {
            o[i & 3] = __builtin_amdgcn_mfma_f32_32x32x16_bf16(a[i % PFD], pb[i >> 3][(i >> 2) & 1], o[i & 3], 0, 0, 0);
            if (i + PFD < 16) a[i % PFD] = ld(i + PFD);
        }
        __builtin_amdgcn_sched_group_barrier(0x100, PFD, 0);
#pragma unroll
        for (int i = 0; i < 16; ++i) { __builtin_amdgcn_sched_group_barrier(0x008, 1, 0); __builtin_amdgcn_sched_group_barrier(0x100, 1, 0); }
        __builtin_amdgcn_sched_barrier(0);
    };
    int k0 = 0, knext = KSLOT, k2 = 2 * KSLOT, k3 = 3 * KSLOT, vcur = 0, v1 = VTILE, v2 = 2 * VTILE;
    const int jl = ntile - 1;
    dma_k(jl, 0); dma_v(jl, 0); dma_k(jl - 1, KSLOT);
    dma_k(jl - 2, 2 * KSLOT); dma_v(jl - 1, VTILE);
    if (MLA) asm volatile("s_waitcnt vmcnt(5)\n\ts_barrier" ::: "memory"); else asm volatile("s_waitcnt vmcnt(4)\n\ts_barrier" ::: "memory");
    if (grpB) qk(0);
    for (int j = jl; j >= 0; --j) {
        if (j >= 3) dma_k(j - 3, k3);
        if (j >= 2) dma_v(j - 2, v2);
        if (!grpB) { if (j <= my_last) { qk(k0); sm(j); pv(vcur); } }
        else { if (j <= my_last) { sm(j); pv(vcur); } if (j > 0 && j - 1 <= my_last) qk(knext); }
        if (j >= 3) { if (MLA) asm volatile("s_waitcnt vmcnt(5) lgkmcnt(0)\n\ts_barrier" ::: "memory"); else asm volatile("s_waitcnt vmcnt(4) lgkmcnt(0)\n\ts_barrier" ::: "memory"); }
        else if (j == 2) asm volatile("s_waitcnt vmcnt(2) lgkmcnt(0)\n\ts_barrier" ::: "memory");
        else asm volatile("s_waitcnt vmcnt(0) lgkmcnt(0)\n\ts_barrier" ::: "memory");
        { const int t = k0; k0 = knext; knext = k2; k2 = k3; k3 = t; const int tv = vcur; vcur = v1; v1 = v2; v2 = tv; }
    }
    const float ltot = lrun + __shfl_xor(lrun, 32);
    const float inv = 1.0f / ltot;
    bf16_t* orow = P.O + (tokb + q0 + r32) * 1024 + h * 128;
#pragma unroll
    for (int dvb = 0; dvb < 4; ++dvb)
#pragma unroll
        for (int g = 0; g < 4; ++g) { u32x2 w; w.x = pg8::cvt_pk_bf16(o[dvb][4 * g] * inv, o[dvb][4 * g + 1] * inv); w.y = pg8::cvt_pk_bf16(o[dvb][4 * g + 2] * inv, o[dvb][4 * g + 3] * inv);
            *(u32x2*)(orow + 32 * dvb + 8 * g + 4 * hi) = w; }
}
template <bool MLA>
__device__ __forceinline__ void attn_unit(LAS unsigned char* lds, const AttnPtrs& P, int b, int h, int qblk) {
    if (__builtin_amdgcn_readfirstlane(threadIdx.x >> 6) < 4) attn_unit_g<MLA, false>(lds, P, b, h, qblk);
    else attn_unit_g<MLA, true>(lds, P, b, h, qblk);
}

#define XB_TMO      128
#define XB_XCNT(j)  (256  + 64 * (j))
#define XB_XSUB(j)  (1280 + 64 * (j))
#define XB_XGEN(j)  (2304 + 64 * (j))
#define XB_TOP      3328
#define XB_TOPGEN   3392
#define XCD_BAR_WORDS 3456
#define XB_SPIN_CAP (1u << 18)

__device__ __forceinline__ unsigned xb_ld(unsigned* p)              { return __hip_atomic_load(p, __ATOMIC_RELAXED, __HIP_MEMORY_SCOPE_AGENT); }
__device__ __forceinline__ unsigned xb_add(unsigned* p, unsigned v) { return __hip_atomic_fetch_add(p, v, __ATOMIC_RELAXED, __HIP_MEMORY_SCOPE_AGENT); }
__device__ __forceinline__ unsigned xb_xcc_id() { return (unsigned)__builtin_amdgcn_s_getreg((3 << 11) | 20) & 0xFu; }
#define XB_SPIN(cond, bar) do { unsigned _sp = 0; while (cond) { __builtin_amdgcn_s_sleep(1); \
    if ((++_sp & 255u) == 0u) { if (xb_ld(&(bar)[XB_TMO])) break; if (_sp > XB_SPIN_CAP) { atomicAdd(&(bar)[XB_TMO], 1u); break; } } } } while (0)

struct XcdBarrier {
    unsigned* bar; unsigned x;
    volatile LAS unsigned* st;
};

__device__ __forceinline__ XcdBarrier xcd_barrier_post(unsigned* bar, volatile LAS unsigned* st) {
    XcdBarrier b; b.bar = bar; b.x = xb_xcc_id(); b.st = st;
    if (threadIdx.x == 0) (void)xb_add(&bar[XB_XCNT(b.x)], 1u);
    return b;
}
__device__ __forceinline__ void xcd_barrier_complete(unsigned* bar, unsigned x, unsigned& nloc, unsigned& nx) {
    const unsigned G = gridDim.x * gridDim.y * gridDim.z;
    unsigned sum, cnt, mine, sp = 0u;
    for (;;) {
        sum = 0u; cnt = 0u; mine = 0u;
#pragma unroll
        for (unsigned j = 0; j < 16; ++j) { const unsigned c = xb_ld(&bar[XB_XCNT(j)]); sum += c; cnt += (c > 0u) ? 1u : 0u; mine = (j == x) ? c : mine; }
        if (sum == G) break;
        __builtin_amdgcn_s_sleep(1);
        if ((++sp & 255u) == 0u) { if (xb_ld(&bar[XB_TMO])) break; if (sp > XB_SPIN_CAP) { atomicAdd(&bar[XB_TMO], 1u); break; } }
    }
    nloc = mine > 0u ? mine : 1u; nx = cnt > 0u ? cnt : 1u;
}

__device__ __forceinline__ void xcd_barrier(const XcdBarrier& b) {
    asm volatile("s_waitcnt vmcnt(0)" ::: "memory");
    __syncthreads();
    if (threadIdx.x == 0) {
        unsigned* bar = b.bar;
        __builtin_amdgcn_s_waitcnt(0);
        unsigned nloc = b.st[0], nx = b.st[1];
        if (nloc == 0u) { xcd_barrier_complete(bar, b.x, nloc, nx); b.st[0] = nloc; b.st[1] = nx; }
        const unsigned old = xb_add(&bar[XB_XSUB(b.x)], 1u);
        const unsigned gen = old / nloc;
        if (old + 1u == (gen + 1u) * nloc) {
            __builtin_amdgcn_fence(__ATOMIC_RELEASE, "agent");
            asm volatile("s_waitcnt vmcnt(0)" ::: "memory");
            const unsigned og = xb_add(&bar[XB_TOP], 1u);
            const unsigned tg = og / nx;
            if (og + 1u == (tg + 1u) * nx) xb_add(&bar[XB_TOPGEN], 1u);
            else XB_SPIN(xb_ld(&bar[XB_TOPGEN]) == tg, bar);
            __builtin_amdgcn_fence(__ATOMIC_ACQUIRE, "agent");
            xb_add(&bar[XB_XGEN(b.x)], 1u);
            asm volatile("s_waitcnt vmcnt(0)" ::: "memory");
        } else {
            XB_SPIN(xb_ld(&bar[XB_XGEN(b.x)]) == gen, bar);
            __builtin_amdgcn_fence(__ATOMIC_ACQUIRE, "agent");
            asm volatile("s_waitcnt vmcnt(0)" ::: "memory");
        }
    }
    __syncthreads();
}


#ifndef MLA_REPS
#define MLA_REPS 1
#endif
#ifndef FOX_REPS
#define FOX_REPS 1
#endif
#ifndef ATTN_REPS
#define ATTN_REPS 1
#endif
#ifndef UP_REPS
#define UP_REPS 1
#endif
struct Args { const float* in[20]; float* out; unsigned char* ws; float inv_freq[32]; };
enum { I_X = 0, I_POS, I_PRE_MIX, I_WIN, I_QAN, I_WUQ, I_KVAN, I_WUKV, I_BFORGET, I_BGATE, I_WBM, I_WBF, I_WOUT, I_POST_MIX, I_PRE_FFN, I_WUP, I_CONVW, I_CONVB, I_WDOWN, I_POST_FFN };

__device__ __forceinline__ float gelu_tanh(float x) {
    const float z = 0.7978845608028654f * (x + 0.044715f * x * x * x);
    return x * __builtin_amdgcn_rcpf(1.0f + __expf(-2.0f * z));
}

#define PTRS() \
    unsigned char* ws = a.ws; float* outp = a.out; asm volatile("" : "+s"(ws), "+s"(outp)); \
    const float* x = a.in[I_X]; (void)x; \
    bf16_t* Win_t = (bf16_t*)(ws + WS_WIN); bf16_t* Wv_t = (bf16_t*)(ws + WS_WV); bf16_t* Wuq_t = (bf16_t*)(ws + WS_WUQ); bf16_t* Wkn_t = (bf16_t*)(ws + WS_WKN); \
    bf16_t* Wvm_t = (bf16_t*)(ws + WS_WVM); bf16_t* Wbm_t = (bf16_t*)(ws + WS_WBM); bf16_t* Wbf_t = (bf16_t*)(ws + WS_WBF); bf16_t* Wout_t = (bf16_t*)(ws + WS_WOUT); \
    bf16_t* Wup_t = (bf16_t*)(ws + WS_WUP); bf16_t* Wdn_t = (bf16_t*)(ws + WS_WDN); \
    bf16_t* H = (bf16_t*)(ws + WS_H); bf16_t* PROJ = (bf16_t*)(ws + WS_PROJ); bf16_t* VTF = (bf16_t*)(ws + WS_VTF); \
    bf16_t* QN = (bf16_t*)(ws + WS_QN); bf16_t* KVN = (bf16_t*)(ws + WS_KVN); bf16_t* KPE = (bf16_t*)(ws + WS_KPE); \
    float* COS = (float*)(ws + WS_COS); float* SIN = (float*)(ws + WS_SIN); float* CL = (float*)(ws + WS_CL); \
    bf16_t* Q = (bf16_t*)(ws + WS_Q); bf16_t* KN = (bf16_t*)(ws + WS_KN); bf16_t* VTM = (bf16_t*)(ws + WS_VTM); \
    bf16_t* OM = (bf16_t*)outp; bf16_t* OF = (bf16_t*)((unsigned char*)outp + 64 * MiB); bf16_t* MERGED = (bf16_t*)((unsigned char*)outp + 128 * MiB); \
    bf16_t* Y = (bf16_t*)(ws + WS_Y); bf16_t* X1 = (bf16_t*)(ws + WS_X1); float* OUT = outp; \
    bf16_t* ACT = (bf16_t*)(ws + WS_ACT); bf16_t* FF = (bf16_t*)(ws + WS_FF); float* HU = (float*)(ws + WS_HU);

__global__ void __launch_bounds__(512, 2) mega_fwd(Args a) {
    extern __shared__ __attribute__((aligned(16))) unsigned char lds_raw[];
    LAS unsigned char* lds = (LAS unsigned char*)lds_raw;
    cg::grid_group grid = cg::this_grid();
    const int tid = threadIdx.x, lane = tid & 63, wave = __builtin_amdgcn_readfirstlane(tid >> 6);
    const int G = gridDim.x, bx = blockIdx.x;
    const int gw = bx * 8 + wave, NGW = G * 8;
    if (tid < 2) ((volatile LAS unsigned*)(lds + LDS_MISC))[tid] = 0u;
    __syncthreads();
    const XcdBarrier xbar = xcd_barrier_post((unsigned*)(a.ws + WS_BAR), (volatile LAS unsigned*)(lds + LDS_MISC));
    if (a.ws == nullptr) grid.sync();
    { PTRS();
    {
        LAS float* scr = (LAS float*)(lds + wave * 16384);
        constexpr int I0 = 251 * 32, I1 = 48 * 8, I2 = 64 * 4, I3 = 64 * 16, I4 = 64 * 16, I5 = 64 * 32, I6 = 352 * 32, I7 = 64 * 88;
        constexpr int NIT = I0 + I1 + I2 + I3 + I4 + I5 + I6 + I7;
        for (int it = gw; it < NIT; it += NGW) {
            int r = it;
            if (r < I0) { transpose_item(a.in[I_WIN], 2048, 8008, 1, nullptr, Win_t, Wv_t, scr, r, lane); continue; } r -= I0;
            if (r < I1) { transpose_item(a.in[I_WUQ], 512, 1536, 2, a.in[I_QAN], Wuq_t, nullptr, scr, r, lane); continue; } r -= I1;
            if (r < I2) { transpose_item(a.in[I_WUKV], 256, 2048, 3, a.in[I_KVAN], Wkn_t, Wvm_t, scr, r, lane); continue; } r -= I2;
            if (r < I3) { transpose_item(a.in[I_WBM], 1024, 2048, 0, nullptr, Wbm_t, nullptr, scr, r, lane); continue; } r -= I3;
            if (r < I4) { transpose_item(a.in[I_WBF], 1024, 2048, 0, nullptr, Wbf_t, nullptr, scr, r, lane); continue; } r -= I4;
            if (r < I5) { transpose_item(a.in[I_WOUT], 2048, 2048, 0, nullptr, Wout_t, nullptr, scr, r, lane); continue; } r -= I5;
            if (r < I6) { transpose_item(a.in[I_WUP], 2048, DFF2, 4, nullptr, Wup_t, nullptr, scr, r, lane); continue; } r -= I6;
            transpose_item(a.in[I_WDOWN], DFF, 2048, 0, nullptr, Wdn_t, nullptr, scr, r, lane);
        }
        { u32x4* z = (u32x4*)(Win_t + (size_t)PC_END * 2048); const int nz = (NPROJ - PC_END) * 2048 / 8;
          for (int i = bx * 512 + tid; i < nz; i += G * 512) z[i] = (u32x4){0u, 0u, 0u, 0u}; }
        for (int m0 = gw * 2; m0 < T; m0 += NGW * 2) {
            f32x4 xv[2][8]; const f32x4* gr = (const f32x4*)a.in[I_PRE_MIX] + lane;
#pragma unroll
            for (int u = 0; u < 2; ++u) { const f32x4* xr = (const f32x4*)(x + (size_t)(m0 + u) * DM) + lane;
#pragma unroll
                for (int j = 0; j < 8; ++j) xv[u][j] = xr[64 * j]; }
#pragma unroll
            for (int u = 0; u < 2; ++u) { float s = 0.f;
#pragma unroll
                for (int j = 0; j < 8; ++j) { const f32x4 v = xv[u][j]; s += (v.x * v.x + v.y * v.y) + (v.z * v.z + v.w * v.w); }
                const float r = rsqrtf(wave_sum(s) * (1.f / DM) + EPS);
                u32x2* o8 = (u32x2*)(H + (size_t)(m0 + u) * DM) + lane;
#pragma unroll
                for (int j = 0; j < 8; ++j) { const f32x4 v = xv[u][j], gg = gr[64 * j]; u32x2 w; w.x = pk2(v.x * r * gg.x, v.y * r * gg.y); w.y = pk2(v.z * r * gg.z, v.w * r * gg.w); o8[64 * j] = w; }
            }
        }
        const int* pos = (const int*)a.in[I_POS];
        for (int i = bx * 512 + tid; i < T * 32; i += G * 512) { const int tk = i >> 5, fi = i & 31; const float ang = (float)pos[tk] * a.inv_freq[fi]; float sn, cs; sincos_acc(ang, sn, cs); COS[i] = cs; SIN[i] = sn; }
    }
    }
    xcd_barrier(xbar);


    { PTRS();
    {
        pg8::Gemm g{H, Win_t, T, NPROJ, DM}; pg8::StaticOrder S; S.init(T, NPROJ, G, bx);
        pg8::Epi<1> E{PROJ, NPROJ, a.in[I_BGATE], nullptr, 0, nullptr, nullptr, 16, lds + LDS_STG};
        pg8::gemm_phase<pg8::Epi<1>, pg8::StaticOrder, true, true>(lds, g, S, E);
    }
    {
        pg8::Gemm g{Wv_t, H, 1024, T, DM}; pg8::StaticOrder S; S.init(1024, T, G, bx);
        pg8::Epi<0> E{VTF, T, nullptr, nullptr, 0, nullptr, nullptr, 0, lds + LDS_STG};
        pg8::gemm_phase<pg8::Epi<0>, pg8::StaticOrder, true, true>(lds, g, S, E);
    }
    }
    xcd_barrier(xbar);

    { PTRS();
    for (int m0 = gw * 4; m0 < T; m0 += NGW * 4) {
        u32x4 wq[4]; u32x2 wk[4]; float k1[4], k2[4], cc[4], ss[4];
#pragma unroll
        for (int u = 0; u < 4; ++u) { const bf16_t* pr = PROJ + (size_t)(m0 + u) * NPROJ;
            wq[u] = *(const u32x4*)(pr + PC_QLAT + 8 * lane); wk[u] = *(const u32x2*)(pr + PC_KVLAT + 4 * lane);
            k1[u] = bf1(pr[PC_KPE + (lane & 31)]); k2[u] = bf1(pr[PC_KPE + 32 + (lane & 31)]); cc[u] = COS[(size_t)(m0 + u) * 32 + (lane & 31)]; ss[u] = SIN[(size_t)(m0 + u) * 32 + (lane & 31)]; }
#pragma unroll
        for (int u = 0; u < 4; ++u) { const int m = m0 + u;
            { const u32x4 w = wq[u];
              float v[8] = {bflo(w.x), bfhi(w.x), bflo(w.y), bfhi(w.y), bflo(w.z), bfhi(w.z), bflo(w.w), bfhi(w.w)}; float s = 0.f;
#pragma unroll
              for (int j = 0; j < 8; ++j) s += v[j] * v[j];
              const float r = rsqrtf(wave_sum(s) * (1.f / 512) + EPS);
              u32x4 o; o.x = pk2(v[0] * r, v[1] * r); o.y = pk2(v[2] * r, v[3] * r); o.z = pk2(v[4] * r, v[5] * r); o.w = pk2(v[6] * r, v[7] * r);
              *(u32x4*)(QN + (size_t)m * 512 + 8 * lane) = o; }
            { const u32x2 w = wk[u];
              float v[4] = {bflo(w.x), bfhi(w.x), bflo(w.y), bfhi(w.y)}; float s = (v[0] * v[0] + v[1] * v[1]) + (v[2] * v[2] + v[3] * v[3]);
              const float r = rsqrtf(wave_sum(s) * (1.f / 256) + EPS);
              u32x2 o; o.x = pk2(v[0] * r, v[1] * r); o.y = pk2(v[2] * r, v[3] * r);
              *(u32x2*)(KVN + (size_t)m * 256 + 4 * lane) = o; }
            if (lane < 32) { const int p1 = 8 * (lane >> 2) + (lane & 3);
              KPE[(size_t)m * 64 + p1] = (bf16_t)f2bf(k1[u] * cc[u] - k2[u] * ss[u]); KPE[(size_t)m * 64 + p1 + 4] = (bf16_t)f2bf(k2[u] * cc[u] + k1[u] * ss[u]); }
        }
    }
#ifndef NO_SCAN
    for (int bh = gw; bh < NB * NH; bh += NGW) {
        const int b = bh >> 3, hh = bh & 7; const float bfg = a.in[I_BFORGET][hh];
        float lf[32]; float run = 0.f;
#pragma unroll
        for (int i = 0; i < 32; ++i) { const float f = bf1(PROJ[((size_t)b * SEQ + 32 * lane + i) * NPROJ + PC_FLOG + hh]) + bfg; run += -logf(1.0f + expf(-f)); lf[i] = run; }
        float incl = run;
#pragma unroll
        for (int o = 1; o < 64; o <<= 1) { const float t = __shfl_up(incl, o); if (lane >= o) incl += t; }
        const float base = incl - run;
#pragma unroll
        for (int i = 0; i < 32; ++i) CL[(size_t)bh * SEQ + 32 * lane + i] = -(base + lf[i]) * LOG2E;
    }
#endif
    }
    xcd_barrier(xbar);

    { PTRS();
    {
        pg8::Gemm g{QN, Wuq_t, T, 1536, 512}; pg8::StaticOrder S; S.init(T, 1536, G, bx);
        pg8::Epi<2> E{Q, 1536, nullptr, nullptr, 0, COS, SIN, 4, lds + LDS_STG};
        pg8::gemm_phase<pg8::Epi<2>, pg8::StaticOrder, true, true>(lds, g, S, E);
    }
    {
        pg8::Gemm g{KVN, Wkn_t, T, 1024, 256}; pg8::StaticOrder S; S.init(T, 1024, G, bx);
        pg8::Epi<0> E{KN, 1024, nullptr, nullptr, 0, nullptr, nullptr, 0, lds + LDS_STG};
        pg8::gemm_phase<pg8::Epi<0>, pg8::StaticOrder, true, true>(lds, g, S, E);
    }
    {
        pg8::Gemm g{Wvm_t, KVN, 1024, T, 256}; pg8::StaticOrder S; S.init(1024, T, G, bx);
        pg8::Epi<0> E{VTM, T, nullptr, nullptr, 0, nullptr, nullptr, 0, lds + LDS_STG};
        pg8::gemm_phase<pg8::Epi<0>, pg8::StaticOrder, true, true>(lds, g, S, E);
    }
    }
    xcd_barrier(xbar);

    for (int rep_ = 0; rep_ < ATTN_REPS; ++rep_) { PTRS();
    {
        const AttnPtrs PM{Q, PROJ, KN, KPE, VTM, CL, OM};
        const AttnPtrs PF{Q, PROJ, KN, KPE, VTF, CL, OF};
        for (int rm_ = 0; rm_ < MLA_REPS; ++rm_)
        for (int idx = bx; idx < 1024; idx += G) {
            const int c = idx & 255, r = idx >> 8, bh = c >> 1;
            const int qb = (c & 1) ? ((r == 0) ? 2 : (r == 1) ? 5 : (r == 2) ? 3 : 4) : ((r == 0) ? 0 : (r == 1) ? 7 : (r == 2) ? 1 : 6);
#ifndef NO_MLA
            attn_unit<true>(lds, PM, bh >> 3, bh & 7, qb);
#endif
        }
        for (int rf_ = 0; rf_ < FOX_REPS; ++rf_)
        for (int idx = bx; idx < 1024; idx += G) {
            const int c = idx & 255, r = idx >> 8, bh = c >> 1;
            const int qb = (c & 1) ? ((r == 0) ? 2 : (r == 1) ? 5 : (r == 2) ? 3 : 4) : ((r == 0) ? 0 : (r == 1) ? 7 : (r == 2) ? 1 : 6);
#ifndef NO_FOX
            attn_unit<false>(lds, PF, bh >> 3, bh & 7, qb);
#endif
        }
    }
    }
    xcd_barrier(xbar);

    { PTRS();
    {
        pg8::Gemm g{OM, Wbm_t, T, DM, 1024}; pg8::StaticOrder S; S.init(T, DM, G, bx);
        pg8::Epi<3> E{MERGED, DM, nullptr, PROJ + PC_GATE, NPROJ, nullptr, nullptr, 0, lds + LDS_STG};
        pg8::gemm_phase<pg8::Epi<3>, pg8::StaticOrder, true, true>(lds, g, S, E);
    }
    {
        pg8::Gemm g{OF, Wbf_t, T, DM, 1024}; pg8::StaticOrder S; S.init(T, DM, G, bx);
        pg8::Epi<4> E{MERGED, DM, nullptr, PROJ + PC_GATE + 2048, NPROJ, nullptr, nullptr, 0, lds + LDS_STG};
        pg8::gemm_phase<pg8::Epi<4>, pg8::StaticOrder, true, true>(lds, g, S, E);
    }
    }
    xcd_barrier(xbar);

    { PTRS();
    {
        pg8::Gemm g{MERGED, Wout_t, T, DM, DM}; pg8::StaticOrder S; S.init(T, DM, G, bx);
        pg8::Epi<0> E{Y, DM, nullptr, nullptr, 0, nullptr, nullptr, 0, lds + LDS_STG};
        pg8::gemm_phase<pg8::Epi<0>, pg8::StaticOrder, true, true>(lds, g, S, E);
    }
    }
    xcd_barrier(xbar);

    { PTRS();
    const f32x4* g1 = (const f32x4*)a.in[I_POST_MIX] + lane; const f32x4* g2 = (const f32x4*)a.in[I_PRE_FFN] + lane;
    for (int m0 = gw * 2; m0 < T; m0 += NGW * 2) {
        u32x2 yw[2][8]; f32x4 xv[2][8];
#pragma unroll
        for (int u = 0; u < 2; ++u) { const u32x2* yr = (const u32x2*)(Y + (size_t)(m0 + u) * DM) + lane; const f32x4* xr = (const f32x4*)(x + (size_t)(m0 + u) * DM) + lane;
#pragma unroll
            for (int j = 0; j < 8; ++j) { yw[u][j] = yr[64 * j]; xv[u][j] = xr[64 * j]; } }
#pragma unroll
        for (int u = 0; u < 2; ++u) { const int m = m0 + u;
            f32x4 v[8]; float s = 0.f;
#pragma unroll
            for (int j = 0; j < 8; ++j) { const u32x2 w_ = yw[u][j]; v[j] = (f32x4){bflo(w_.x), bfhi(w_.x), bflo(w_.y), bfhi(w_.y)}; s += (v[j].x * v[j].x + v[j].y * v[j].y) + (v[j].z * v[j].z + v[j].w * v[j].w); }
            const float r = rsqrtf(wave_sum(s) * (1.f / DM) + EPS);
            float s2 = 0.f;
#pragma unroll
            for (int j = 0; j < 8; ++j) { v[j] = xv[u][j] + v[j] * r * g1[64 * j]; s2 += (v[j].x * v[j].x + v[j].y * v[j].y) + (v[j].z * v[j].z + v[j].w * v[j].w); }
            const float r2 = rsqrtf(wave_sum(s2) * (1.f / DM) + EPS);
            u32x2* xo = (u32x2*)(X1 + (size_t)m * DM) + lane; u32x2* ho = (u32x2*)(H + (size_t)m * DM) + lane;
#pragma unroll
            for (int j = 0; j < 8; ++j) { u32x2 xw; xw.x = pk2(v[j].x, v[j].y); xw.y = pk2(v[j].z, v[j].w); xo[64 * j] = xw; const f32x4 gg = g2[64 * j]; u32x2 w; w.x = pk2(v[j].x * r2 * gg.x, v[j].y * r2 * gg.y); w.y = pk2(v[j].z * r2 * gg.z, v[j].w * r2 * gg.w); ho[64 * j] = w; }
        }
    }
    }
    xcd_barrier(xbar);

    for (int rep_ = 0; rep_ < UP_REPS; ++rep_) { PTRS();
        pg8::Gemm g{H, Wup_t, T, DFF2, DM}; pg8::StaticOrder S; S.init(T, DFF2, G, bx);
        pg8::EpiConv E{ACT, HU, a.in[I_CONVW], a.in[I_CONVB], lds + 131072, DFF2 / 256, DFF};
        pg8::gemm_phase<pg8::EpiConv, pg8::StaticOrder, true, true>(lds, g, S, E);
    }
    xcd_barrier(xbar);
    { PTRS();
        const float* cw = a.in[I_CONVW]; const float* cb = a.in[I_CONVB];
        constexpr int NN = DFF2 / 256;
        for (int i = bx * 512 + tid; i < (T / 256) * NN * 32; i += G * 512) {
            const int c4 = (i & 31) * 4, pn = (i >> 5) % NN, pm = (i >> 5) / NN, ch0 = pn * 128 + c4;
            const bool first = (pm & 7) == 0;
            f32x4 tg[2], tv[2], pg[2], pv[2];
#pragma unroll
            for (int sl = 0; sl < 2; ++sl) {
                tg[sl] = *(const f32x4*)(HU + ((size_t)(pm * 4 + sl) * NN + pn) * 256 + c4); tv[sl] = *(const f32x4*)(HU + ((size_t)(pm * 4 + sl) * NN + pn) * 256 + 128 + c4);
                if (!first) { pg[sl] = *(const f32x4*)(HU + ((size_t)((pm - 1) * 4 + 2 + sl) * NN + pn) * 256 + c4); pv[sl] = *(const f32x4*)(HU + ((size_t)((pm - 1) * 4 + 2 + sl) * NN + pn) * 256 + 128 + c4); }
                else { pg[sl] = (f32x4){0.f, 0.f, 0.f, 0.f}; pv[sl] = pg[sl]; }
            }
            const f32x4 wg0 = *(const f32x4*)(cw + ch0), wg1 = *(const f32x4*)(cw + DFF2 + ch0), wg2 = *(const f32x4*)(cw + 2 * DFF2 + ch0);
            const f32x4 wv0 = *(const f32x4*)(cw + DFF + ch0), wv1 = *(const f32x4*)(cw + DFF2 + DFF + ch0), wv2 = *(const f32x4*)(cw + 2 * DFF2 + DFF + ch0);
            const f32x4 bg = *(const f32x4*)(cb + ch0), bv = *(const f32x4*)(cb + DFF + ch0);
            const f32x4 g_r0 = wg2 * tg[0] + wg1 * pg[1] + wg0 * pg[0] + bg, v_r0 = wv2 * tv[0] + wv1 * pv[1] + wv0 * pv[0] + bv;
            const f32x4 g_r1 = wg2 * tg[1] + wg1 * tg[0] + wg0 * pg[1] + bg, v_r1 = wv2 * tv[1] + wv1 * tv[0] + wv0 * pv[1] + bv;
            u32x2 w0, w1;
            w0.x = pk2(gelu_tanh(g_r0[0]) * v_r0[0], gelu_tanh(g_r0[1]) * v_r0[1]); w0.y = pk2(gelu_tanh(g_r0[2]) * v_r0[2], gelu_tanh(g_r0[3]) * v_r0[3]);
            w1.x = pk2(gelu_tanh(g_r1[0]) * v_r1[0], gelu_tanh(g_r1[1]) * v_r1[1]); w1.y = pk2(gelu_tanh(g_r1[2]) * v_r1[2], gelu_tanh(g_r1[3]) * v_r1[3]);
            *(u32x2*)(ACT + (size_t)(pm * 256) * DFF + ch0) = w0; *(u32x2*)(ACT + (size_t)(pm * 256 + 1) * DFF + ch0) = w1;
        }
    }
    xcd_barrier(xbar);
    { PTRS();
        pg8::Gemm g{ACT, Wdn_t, T, DM, DFF}; pg8::StaticOrder S; S.init(T, DM, G, bx);
        pg8::Epi<0> E{FF, DM, nullptr, nullptr, 0, nullptr, nullptr, 0, lds + LDS_STG};
        pg8::gemm_phase<pg8::Epi<0>, pg8::StaticOrder, true, true>(lds, g, S, E);
    }
    xcd_barrier(xbar);
    { PTRS();
        const f32x4* g1 = (const f32x4*)a.in[I_POST_FFN] + lane;
        for (int m0 = gw * 2; m0 < T; m0 += NGW * 2) {
            u32x2 fw[2][8]; u32x2 xv[2][8];
#pragma unroll
            for (int u = 0; u < 2; ++u) { const u32x2* fr_ = (const u32x2*)(FF + (size_t)(m0 + u) * DM) + lane; const u32x2* xr = (const u32x2*)(X1 + (size_t)(m0 + u) * DM) + lane;
#pragma unroll
                for (int j = 0; j < 8; ++j) { fw[u][j] = fr_[64 * j]; xv[u][j] = xr[64 * j]; } }
#pragma unroll
            for (int u = 0; u < 2; ++u) {
                f32x4 v[8]; float s = 0.f;
#pragma unroll
                for (int j = 0; j < 8; ++j) { const u32x2 w_ = fw[u][j]; v[j] = (f32x4){bflo(w_.x), bfhi(w_.x), bflo(w_.y), bfhi(w_.y)}; s += (v[j].x * v[j].x + v[j].y * v[j].y) + (v[j].z * v[j].z + v[j].w * v[j].w); }
                const float r = rsqrtf(wave_sum(s) * (1.f / DM) + EPS);
                f32x4* xo = (f32x4*)(OUT + (size_t)(m0 + u) * DM) + lane;
#pragma unroll
                for (int j = 0; j < 8; ++j) { const u32x2 xw = xv[u][j]; xo[64 * j] = (f32x4){bflo(xw.x), bfhi(xw.x), bflo(xw.y), bfhi(xw.y)} + v[j] * r * g1[64 * j]; }
            }
        }
    }
}

extern "C" void kernel_launch(void* const* d_in, const int* in_sizes, int n_in, void* d_out, int out_size, void* d_ws, size_t ws_size, hipStream_t stream) {
    static int grid = 0;
    if (grid == 0) {
        if (n_in != 20 || ws_size < WS_END) { fprintf(stderr, "kernel_launch: unexpected n_in %d / ws_size %zu\n", n_in, ws_size); grid = -1; return; }
        int dev = 0, cus = 0, per_cu = 0;
        hipGetDevice(&dev); hipDeviceGetAttribute(&cus, hipDeviceAttributeMultiprocessorCount, dev);
        hipFuncSetAttribute((const void*)mega_fwd, hipFuncAttributeMaxDynamicSharedMemorySize, LDS_BYTES);
        hipOccupancyMaxActiveBlocksPerMultiprocessor(&per_cu, (const void*)mega_fwd, 512, LDS_BYTES);
        if (per_cu < 1) { fprintf(stderr, "kernel_launch: occupancy query says %d blocks per CU\n", per_cu); per_cu = 1; }
        (void)hipGetLastError();
        grid = cus * per_cu;
        if (grid > 256) grid = 256;
    }
    if (grid < 0) return;
    Args a{};
    for (int i = 0; i < 20; ++i) a.in[i] = (const float*)d_in[i];
    a.out = (float*)d_out; a.ws = (unsigned char*)d_ws;
    for (int i = 0; i < 32; ++i) { const float p = (float)pow(10000.0, (double)(2 * i) / 64.0); a.inv_freq[i] = 1.0f / p; }
    void* args[] = {&a};
    (void)hipMemsetAsync((unsigned char*)d_ws + WS_BAR, 0, XCD_BAR_WORDS * 4, stream);
    hipError_t e = hipLaunchCooperativeKernel((const void*)mega_fwd, dim3(grid), dim3(512), args, LDS_BYTES, stream);
    if (e != hipSuccess) fprintf(stderr, "cooperative launch failed: %s (grid %d)\n", hipGetErrorString(e), grid);
}
```
